# Optimizing an MI355X kernel written in HIP

```python
import jax, jax.numpy as jnp
from jax import lax
import numpy as np

D_MODEL = 1024
BATCH = 8
SEQ = 4096
DEPTH = 4

N_A_LAYERS = DEPTH // 2
N_B_LAYERS = DEPTH - N_A_LAYERS
POOL_WINDOWS = (2, 4, 8, 16)
N_POOL_GROUPS = len(POOL_WINDOWS)
POOL_GROUP = D_MODEL // N_POOL_GROUPS
N_HEADS = 8
QK_NOPE = 128
QK_ROPE = 64
V_HEAD = 128
QK_HEAD = QK_NOPE + QK_ROPE
Q_RANK = 3 * D_MODEL // 8
KV_RANK = D_MODEL // 4
ROPE_THETA = 10000.0
Q_BLOCK = 128
D_FF = ((8 * D_MODEL // 3 + 127) // 128) * 128
CONV_WIDTH = 3
EPS = 1e-6
N_MOD = 6
MAX_POS_OFFSET = 1024

kernel_name = "yoco_pool_mla_adaln_convglu"


def rmsnorm(x, g):
    x32 = x.astype(jnp.float32)
    y = x32 * lax.rsqrt(jnp.mean(x32 * x32, axis=-1, keepdims=True) + EPS)
    return y.astype(x.dtype) * g


def modulate(h, shift, scale):
    return h * (1 + scale[:, None, :]) + shift[:, None, :]


def rope_tables(positions):
    inv = 1.0 / (ROPE_THETA ** (jnp.arange(0, QK_ROPE, 2, dtype=jnp.float32) / QK_ROPE))
    ang = positions.astype(jnp.float32)[..., None] * inv
    return jnp.cos(ang), jnp.sin(ang)


def apply_rope(x, cos, sin):
    x32 = x.astype(jnp.float32)
    x1, x2 = jnp.split(x32, 2, axis=-1)
    out = jnp.concatenate([x1 * cos - x2 * sin, x2 * cos + x1 * sin], axis=-1)
    return out.astype(x.dtype)


def trailing_mean_minus_self(h, w):
    s = h.shape[1]
    h32 = h.astype(jnp.float32)
    cs = jnp.cumsum(h32, axis=1)
    cs_lag = jnp.pad(cs, ((0, 0), (w, 0), (0, 0)))[:, :s]
    count = jnp.minimum(jnp.arange(1, s + 1, dtype=jnp.float32), float(w))
    mean = (cs - cs_lag) / count[None, :, None]
    return (mean - h32).astype(h.dtype)


def pool_mixer(h, w_g, b_g, scale):
    bsz, s, d = h.shape
    hg = h.reshape(bsz, s, N_POOL_GROUPS, POOL_GROUP)
    pooled = jnp.stack([trailing_mean_minus_self(hg[:, :, g], POOL_WINDOWS[g])
                        for g in range(N_POOL_GROUPS)], axis=2)
    y = jnp.einsum('bsgc,gcd->bsgd', pooled, w_g).reshape(bsz, s, d) + b_g
    return y * scale


def conv_glu_ffn(h, w_up, conv_w, conv_b, w_down):
    s = h.shape[1]
    a, v = jnp.split(h @ w_up, 2, axis=-1)
    ap = jnp.pad(a, ((0, 0), (CONV_WIDTH - 1, 0), (0, 0)))
    a = sum(ap[:, k:k + s] * conv_w[k] for k in range(CONV_WIDTH)) + conv_b
    return (jax.nn.gelu(a, approximate=False) * v) @ w_down


def shared_kv(x, kv_in_g, w_dkv, ckv_norm_g, w_uk, w_uv, cos, sin):
    bsz, s, _ = x.shape
    kv = rmsnorm(x, kv_in_g) @ w_dkv
    c_kv = rmsnorm(kv[..., :KV_RANK], ckv_norm_g)
    k_rope = apply_rope(kv[..., KV_RANK:], cos, sin)
    k_nope = (c_kv @ w_uk).reshape(bsz, s, N_HEADS, QK_NOPE)
    k = jnp.concatenate([k_nope, jnp.broadcast_to(k_rope[:, :, None, :],
                                                  (bsz, s, N_HEADS, QK_ROPE))], axis=-1)
    v = (c_kv @ w_uv).reshape(bsz, s, N_HEADS, V_HEAD)
    return k, v


def causal_block_attention(q, k, v):
    s = q.shape[1]
    q = q * (QK_HEAD ** -0.5)
    outs = []
    for i in range(s // Q_BLOCK):
        q0 = i * Q_BLOCK
        k_end = q0 + Q_BLOCK
        sc = jnp.einsum('bqhd,bkhd->bhqk', q[:, q0:k_end], k[:, :k_end],
                        preferred_element_type=jnp.float32)
        mask = jnp.arange(k_end)[None, :] <= jnp.arange(q0, k_end)[:, None]
        sc = jnp.where(mask, sc, jnp.finfo(jnp.float32).min)
        p = jax.nn.softmax(sc, axis=-1).astype(v.dtype)
        outs.append(jnp.einsum('bhqk,bkhd->bqhd', p, v[:, :k_end]))
    return jnp.concatenate(outs, axis=1)


def mla_mixer(h, k, v, w_dq, q_norm_g, w_uq, w_o, cos, sin):
    bsz, s, _ = h.shape
    c_q = rmsnorm(h @ w_dq, q_norm_g)
    q = (c_q @ w_uq).reshape(bsz, s, N_HEADS, QK_HEAD)
    q = jnp.concatenate([q[..., :QK_NOPE],
                         apply_rope(q[..., QK_NOPE:], cos[:, :, None], sin[:, :, None])], axis=-1)
    o = causal_block_attention(q, k, v)
    return o.reshape(bsz, s, N_HEADS * V_HEAD) @ w_o


def setup_inputs(seed: int = 0) -> dict:
    key = jax.random.key(seed)
    ks = jax.random.split(key, 26)
    f32 = jnp.float32
    nrm = lambda k, shape, s: jax.random.normal(k, shape, f32) * s
    d, f = D_MODEL, D_FF
    positions = (jnp.arange(SEQ, dtype=jnp.int32)[None, :]
                 + jax.random.randint(ks[2], (BATCH, 1), 0, MAX_POS_OFFSET, dtype=jnp.int32))
    return {
        "x": nrm(ks[0], (BATCH, SEQ, d), 1.0),
        "c": nrm(ks[1], (BATCH, d), 1.0),
        "positions": positions,
        "mod_w": nrm(ks[3], (DEPTH, d, N_MOD * d), d ** -0.5),
        "mod_b": nrm(ks[4], (DEPTH, N_MOD * d), 0.01),
        "norm1_g": 1.0 + nrm(ks[5], (DEPTH, d), 0.02),
        "norm2_g": 1.0 + nrm(ks[6], (DEPTH, d), 0.02),
        "pool_w": nrm(ks[7], (N_A_LAYERS, N_POOL_GROUPS, POOL_GROUP, POOL_GROUP), POOL_GROUP ** -0.5),
        "pool_b": nrm(ks[8], (N_A_LAYERS, d), 0.01),
        "pool_scale": 1.0 + nrm(ks[9], (N_A_LAYERS, d), 0.1),
        "kv_in_g": 1.0 + nrm(ks[10], (d,), 0.02),
        "w_dkv": nrm(ks[11], (d, KV_RANK + QK_ROPE), d ** -0.5),
        "ckv_norm_g": 1.0 + nrm(ks[12], (KV_RANK,), 0.02),
        "w_uk": nrm(ks[13], (KV_RANK, N_HEADS * QK_NOPE), KV_RANK ** -0.5),
        "w_uv": nrm(ks[14], (KV_RANK, N_HEADS * V_HEAD), KV_RANK ** -0.5),
        "w_dq": nrm(ks[15], (N_B_LAYERS, d, Q_RANK), d ** -0.5),
        "q_norm_g": 1.0 + nrm(ks[16], (N_B_LAYERS, Q_RANK), 0.02),
        "w_uq": nrm(ks[17], (N_B_LAYERS, Q_RANK, N_HEADS * QK_HEAD), Q_RANK ** -0.5),
        "w_o": nrm(ks[18], (N_B_LAYERS, N_HEADS * V_HEAD, d), (N_HEADS * V_HEAD) ** -0.5),
        "w_up": nrm(ks[19], (DEPTH, d, 2 * f), d ** -0.5),
        "conv_w": nrm(ks[20], (DEPTH, CONV_WIDTH, f), CONV_WIDTH ** -0.5),
        "conv_b": nrm(ks[21], (DEPTH, f), 0.01),
        "w_down": nrm(ks[22], (DEPTH, f, d), f ** -0.5),
        "final_g": 1.0 + nrm(ks[23], (d,), 0.02),
    }


def reference(x, c, positions, mod_w, mod_b, norm1_g, norm2_g, pool_w, pool_b, pool_scale,
              kv_in_g, w_dkv, ckv_norm_g, w_uk, w_uv, w_dq, q_norm_g, w_uq, w_o,
              w_up, conv_w, conv_b, w_down, final_g):
    cos, sin = rope_tables(positions)
    mods = jnp.einsum('bd,lde->lbe', jax.nn.silu(c), mod_w) + mod_b[:, None, :]
    k = v = None
    for l in range(DEPTH):
        sh1, sc1, g1, sh2, sc2, g2 = jnp.split(mods[l], N_MOD, axis=-1)
        h = modulate(rmsnorm(x, norm1_g[l]), sh1, sc1)
        if l < N_A_LAYERS:
            y = pool_mixer(h, pool_w[l], pool_b[l], pool_scale[l])
        else:
            j = l - N_A_LAYERS
            y = mla_mixer(h, k, v, w_dq[j], q_norm_g[j], w_uq[j], w_o[j], cos, sin)
        x = x + g1[:, None, :] * y
        h = modulate(rmsnorm(x, norm2_g[l]), sh2, sc2)
        x = x + g2[:, None, :] * conv_glu_ffn(h, w_up[l], conv_w[l], conv_b[l], w_down[l])
        if l == N_A_LAYERS - 1:
            k, v = shared_kv(x, kv_in_g, w_dkv, ckv_norm_g, w_uk, w_uv, cos, sin)
    return rmsnorm(x, final_g)
```

```cpp
#include <hip/hip_runtime.h>
#include <hip/hip_cooperative_groups.h>
#include <cstdio>
#include <cstdint>
namespace cg = cooperative_groups;

#define LAS __attribute__((address_space(3)))
typedef unsigned short bf16_t;
typedef short bf16x8 __attribute__((ext_vector_type(8)));
typedef short s16x4 __attribute__((ext_vector_type(4)));
typedef float f32x2 __attribute__((ext_vector_type(2)));
typedef float f32x4 __attribute__((ext_vector_type(4)));
typedef float f32x16 __attribute__((ext_vector_type(16)));
typedef unsigned u32x2 __attribute__((ext_vector_type(2)));
typedef unsigned u32x4 __attribute__((ext_vector_type(4)));

constexpr int NB = 8, SEQ = 4096, DM = 1024, MT = NB * SEQ, FF = 2816, NH = 8;
constexpr int NWAVES = 8, NTHR = 512;
constexpr float EPS = 1e-6f;
constexpr size_t MiB = 1u << 20;
constexpr size_t WS_MODS = 0;
constexpr size_t WS_CS = 1 * MiB;
constexpr size_t WS_WUP = 16 * MiB;
constexpr size_t WUP_SZ = (size_t)5632 * 1024 * 2;
constexpr size_t WS_WDN = WS_WUP + WUP_SZ;
constexpr size_t WDN_SZ = (size_t)1024 * 2816 * 2;
constexpr size_t WS_WPOOL = WS_WDN + WDN_SZ;
constexpr size_t WS_WDKV = WS_WPOOL + 1 * MiB;
constexpr size_t WS_WKV = WS_WDKV + 1 * MiB;
constexpr size_t WS_WDQ = WS_WKV + 1 * MiB;
constexpr size_t WS_WUQ = WS_WDQ + 2 * MiB;
constexpr size_t WUQ_SZ = (size_t)1536 * 384 * 2;
constexpr size_t WS_WO = WS_WUQ + 2 * WUQ_SZ + 0;
constexpr size_t WS_WEND = WS_WO + 4 * MiB;
static_assert(WS_WEND <= 45 * MiB, "weights region");
constexpr size_t WS_TOPA = 45 * MiB, WS_TOPV = 48 * MiB, WS_BOTA = 51 * MiB;
constexpr size_t WS_H = 54 * MiB + 4096;
constexpr size_t WS_XB = 119 * MiB;
constexpr size_t WS_KV = 183 * MiB;
constexpr size_t WS_KR = 311 * MiB;
constexpr size_t WS_ACT = 315 * MiB;
constexpr size_t WS_END = 491 * MiB;
constexpr size_t ACT_Q = 0, ACT_O = 96 * MiB, ACT_CQRAW = 96 * MiB, ACT_KVRAW = 128 * MiB, ACT_CKV = 160 * MiB;

constexpr int RING_BYTES = 131072, XCH_OFF = RING_BYTES, LDS_BYTES = 155648;

struct Args {
    const float* x; const float* c; const int* pos; const float* mod_w; const float* mod_b; const float* norm1_g; const float* norm2_g;
    const float* pool_w; const float* pool_b; const float* pool_scale; const float* kv_in_g; const float* w_dkv; const float* ckv_norm_g;
    const float* w_uk; const float* w_uv; const float* w_dq; const float* q_norm_g; const float* w_uq; const float* w_o;
    const float* w_up; const float* conv_w; const float* conv_b; const float* w_down; const float* final_g;
    float* out; unsigned char* ws;
};

typedef const __attribute__((address_space(4))) Args* ArgsP;
#define GAS __attribute__((address_space(1)))
#if defined(__HIP_DEVICE_COMPILE__)
#define ASSUME_GLOBAL(p) __builtin_assume(!__builtin_amdgcn_is_shared((const __attribute__((address_space(0))) void*)(p)) && !__builtin_amdgcn_is_private((const __attribute__((address_space(0))) void*)(p)))
#else
#define ASSUME_GLOBAL(p) ((void)0)
#endif
#define AF(name) ([&]() { const float* p_ = a->name; ASSUME_GLOBAL(p_); return p_; })()
#define AI(name) ([&]() { const int* p_ = a->name; ASSUME_GLOBAL(p_); return p_; })()

__device__ __forceinline__ unsigned f2bf(float f) { unsigned u = __builtin_bit_cast(unsigned, f); return (u + 0x7fffu + ((u >> 16) & 1u)) >> 16; }
__device__ __forceinline__ unsigned pk2(float lo, float hi) { return f2bf(lo) | (f2bf(hi) << 16); }
__device__ __forceinline__ unsigned cvt_pk_bf16(float lo, float hi) { unsigned r; asm volatile("v_cvt_pk_bf16_f32 %0, %1, %2" : "=v"(r) : "v"(lo), "v"(hi)); return r; }
__device__ __forceinline__ float bflo(unsigned u) { return __builtin_bit_cast(float, u << 16); }
__device__ __forceinline__ float bfhi(unsigned u) { return __builtin_bit_cast(float, u & 0xffff0000u); }
__device__ __forceinline__ void swap16_self(unsigned x, unsigned& r0, unsigned& r1) { unsigned y = x; asm("" : "+v"(y)); auto r = __builtin_amdgcn_permlane16_swap(x, y, false, false); r0 = r[0]; r1 = r[1]; }
__device__ __forceinline__ void swap32_self(unsigned x, unsigned& r0, unsigned& r1) { unsigned y = x; asm("" : "+v"(y)); auto r = __builtin_amdgcn_permlane32_swap(x, y, false, false); r0 = r[0]; r1 = r[1]; }
#define DPPF(v, ctrl) __builtin_bit_cast(float, __builtin_amdgcn_update_dpp(0, __builtin_bit_cast(int, (v)), (ctrl), 0xf, 0xf, false))
__device__ __forceinline__ float wave_sum(float v) {
    v += DPPF(v, 0xB1); v += DPPF(v, 0x4E); v += DPPF(v, 0x141); v += DPPF(v, 0x140);
    unsigned a, b;
    swap16_self(__builtin_bit_cast(unsigned, v), a, b); v = __builtin_bit_cast(float, a) + __builtin_bit_cast(float, b);
    swap32_self(__builtin_bit_cast(unsigned, v), a, b); v = __builtin_bit_cast(float, a) + __builtin_bit_cast(float, b);
    return v;
}
#define LDS_WAIT() asm volatile("s_waitcnt lgkmcnt(0)" ::: "memory")

namespace pg8 {
constexpr int BM = 256, BK = 64, HALF = 128, HTB = HALF * BK * 2, NXCD = 8, WGM = 8;
__device__ __forceinline__ int lds_byte(int r, int c) { const int st = (r >> 4) * 2 + (c >> 5), rr = r & 15, cc = c & 31, ob = rr * 64 + cc * 2; return st * 1024 + (ob ^ (((ob >> 9) & 1) << 5)); }
__device__ __forceinline__ void stage_rc(int b, int& R, int& C) { const int st = b / 1024, sb = b % 1024, swz = sb ^ (((sb >> 9) & 1) << 5); R = (st >> 1) * 16 + swz / 64; C = (st & 1) * 32 + (swz % 64) / 2; }
__device__ __forceinline__ int perm32(int rho) { const int n = rho >> 4, i = rho & 15; return 8 * (i >> 2) + 4 * n + (i & 3); }
struct Unit { int pm, pn; };
struct Order {
    int nM, nN, nwg, G, c;
    __device__ void init(int nM_, int nN_, int G_, int c_) { nM = nM_; nN = nN_; nwg = nM * nN; G = G_; c = c_; }
    __device__ bool next(int i, Unit& u) const {
        const long L = (long)i * G + c; if (L >= nwg) return false;
        int wgid = (int)L; { const int q = nwg / NXCD, r = nwg % NXCD, xcd = wgid % NXCD, off = wgid / NXCD; wgid = (xcd < r ? xcd * (q + 1) : r * (q + 1) + (xcd - r) * q) + off; }
        const int nig = WGM * nN, gid = wgid / nig, fm = gid * WGM, gsz = (nM - fm) < WGM ? (nM - fm) : WGM;
        u.pm = fm + ((wgid % nig) % gsz); u.pn = (wgid % nig) / gsz; return true;
    }
};
struct Gemm { const bf16_t* A; const bf16_t* Bt; int lda; int K; int acs; };
template <int MODE> __device__ __forceinline__ ptrdiff_t a_off(const Gemm& g, const Unit& u) {
    if (MODE == 2) { const int b = u.pm / 17, j = u.pm - b * 17; return ((ptrdiff_t)(b * 4096 + j * 254 - 2) * g.lda) * 2; }
    return ((ptrdiff_t)u.pm * 256 * g.lda + (ptrdiff_t)u.pn * g.acs) * 2;
}

__device__ __forceinline__ f32x2 gelu_pk(f32x2 v) {
    const f32x2 z = __builtin_elementwise_min(__builtin_elementwise_max(v, (f32x2){-4.3f, -4.3f}), (f32x2){4.3f, 4.3f}) * 0.232558139534883721f, u = z * z;
    f32x2 q = u * 2.9056504693371608f + (-15.464755185649892f);
    q = q * u + 36.337021862829715f; q = q * u + (-50.1697976120365f); q = q * u + 45.89880639920095f; q = q * u + (-29.836445535451812f);
    q = q * u + 14.38621083521653f; q = q * u + (-5.271915130776272f); q = q * u + 1.7152232528538645f;
    return v * (z * q + 0.5f);
}

struct EpiRes {
    static constexpr bool PERM = true, ROWPERM = false;
    const void* base; int base_f32; bf16_t* out; const float* gate; const float* pb; const float* ps;
    __device__ __forceinline__ void operator()(const f32x4 (&acc)[2][2][4][2], const Unit& u, int wr, int wc, int fr, int fq, LAS unsigned char*, int) const {
        const int b = u.pm >> 4, row0 = u.pm * BM + wr * 64 + fr, col0 = u.pn * BM + wc * 32 + 8 * fq;
        f32x4 mul[2][2], add[2][2];
#pragma unroll
        for (int bj = 0; bj < 2; ++bj)
#pragma unroll
            for (int n = 0; n < 2; ++n) { const int col = col0 + bj * HALF + n * 4; const f32x4 g = *(const GAS f32x4*)(gate + b * 6144 + col);
                if (pb) { const f32x4 s = *(const GAS f32x4*)(ps + col), bb = *(const GAS f32x4*)(pb + col); mul[bj][n] = g * s; add[bj][n] = mul[bj][n] * bb; }
                else { mul[bj][n] = g; add[bj][n] = (f32x4){0.f, 0.f, 0.f, 0.f}; } }
#pragma unroll
        for (int ai = 0; ai < 2; ++ai)
#pragma unroll
            for (int m = 0; m < 4; ++m) { const size_t off = (size_t)(row0 + ai * HALF + m * 16) * DM + col0;
#pragma unroll
                for (int bj = 0; bj < 2; ++bj) { f32x4 b0, b1;
                    if (base_f32) { b0 = *(const GAS f32x4*)((const float*)base + off + bj * HALF); b1 = *(const GAS f32x4*)((const float*)base + off + bj * HALF + 4); }
                    else { const u32x4 w = *(const GAS u32x4*)((const bf16_t*)base + off + bj * HALF); b0 = (f32x4){bflo(w.x), bfhi(w.x), bflo(w.y), bfhi(w.y)}; b1 = (f32x4){bflo(w.z), bfhi(w.z), bflo(w.w), bfhi(w.w)}; }
                    const f32x4 v0 = b0 + acc[ai][bj][m][0] * mul[bj][0] + add[bj][0], v1 = b1 + acc[ai][bj][m][1] * mul[bj][1] + add[bj][1];
                    u32x4 o; o.x = cvt_pk_bf16(v0[0], v0[1]); o.y = cvt_pk_bf16(v0[2], v0[3]); o.z = cvt_pk_bf16(v1[0], v1[1]); o.w = cvt_pk_bf16(v1[2], v1[3]);
                    *(GAS u32x4*)(out + off + bj * HALF) = o; } }
    }
};
struct EpiBf16 {
    static constexpr bool PERM = true, ROWPERM = false;
    bf16_t* O; int ldc;
    __device__ __forceinline__ void operator()(const f32x4 (&acc)[2][2][4][2], const Unit& u, int wr, int wc, int fr, int fq, LAS unsigned char*, int) const {
        const int row0 = u.pm * BM + wr * 64 + fr, col0 = u.pn * BM + wc * 32 + 8 * fq;
#pragma unroll
        for (int ai = 0; ai < 2; ++ai)
#pragma unroll
            for (int m = 0; m < 4; ++m) { bf16_t* rowp = O + (size_t)(row0 + ai * HALF + m * 16) * ldc + col0;
#pragma unroll
                for (int bj = 0; bj < 2; ++bj) { const f32x4 v0 = acc[ai][bj][m][0], v1 = acc[ai][bj][m][1];
                    u32x4 w; w.x = cvt_pk_bf16(v0[0], v0[1]); w.y = cvt_pk_bf16(v0[2], v0[3]); w.z = cvt_pk_bf16(v1[0], v1[1]); w.w = cvt_pk_bf16(v1[2], v1[3]);
                    *(GAS u32x4*)(rowp + bj * HALF) = w; } }
    }
};
struct EpiQ {
    static constexpr bool PERM = true, ROWPERM = false;
    bf16_t* O; const float* cs;
    __device__ __forceinline__ void operator()(const f32x4 (&acc)[2][2][4][2], const Unit& u, int wr, int wc, int fr, int fq, LAS unsigned char*, int) const {
        const int row0 = u.pm * BM + wr * 64 + fr;
#pragma unroll
        for (int bj = 0; bj < 2; ++bj) { const int c0 = u.pn * BM + bj * HALF + wc * 32 + 8 * fq, hc = c0 % 192; const bool rope = hc >= 128; const int i0 = (hc - 128) >> 1;
#pragma unroll
            for (int ai = 0; ai < 2; ++ai)
#pragma unroll
                for (int m = 0; m < 4; ++m) { const int row = row0 + ai * HALF + m * 16; f32x4 v0 = acc[ai][bj][m][0], v1 = acc[ai][bj][m][1];
                    if (rope) { const f32x4 ca = *(const GAS f32x4*)(cs + (size_t)row * 64 + i0 * 2), cb = *(const GAS f32x4*)(cs + (size_t)row * 64 + i0 * 2 + 4);
                        f32x4 r0, r1;
                        r0[0] = v0[0] * ca[0] - v0[1] * ca[1]; r0[1] = v0[1] * ca[0] + v0[0] * ca[1]; r0[2] = v0[2] * ca[2] - v0[3] * ca[3]; r0[3] = v0[3] * ca[2] + v0[2] * ca[3];
                        r1[0] = v1[0] * cb[0] - v1[1] * cb[1]; r1[1] = v1[1] * cb[0] + v1[0] * cb[1]; r1[2] = v1[2] * cb[2] - v1[3] * cb[3]; r1[3] = v1[3] * cb[2] + v1[2] * cb[3];
                        v0 = r0; v1 = r1; }
                    u32x4 w; w.x = cvt_pk_bf16(v0[0], v0[1]); w.y = cvt_pk_bf16(v0[2], v0[3]); w.z = cvt_pk_bf16(v1[0], v1[1]); w.w = cvt_pk_bf16(v1[2], v1[3]);
                    *(GAS u32x4*)(O + (size_t)row * 1536 + c0) = w; } }
    }
};
__device__ __forceinline__ float dpp_prev1(float cur, float prev) {
    const int o = __builtin_amdgcn_mov_dpp(__builtin_bit_cast(int, prev), 0x121, 0xf, 0xf, true);
    return __builtin_bit_cast(float, __builtin_amdgcn_update_dpp(o, __builtin_bit_cast(int, cur), 0x111, 0xf, 0xf, false));
}
__device__ __forceinline__ float dpp_prev2(float cur, float prev) {
    const int o = __builtin_amdgcn_mov_dpp(__builtin_bit_cast(int, prev), 0x122, 0xf, 0xf, true);
    return __builtin_bit_cast(float, __builtin_amdgcn_update_dpp(o, __builtin_bit_cast(int, cur), 0x112, 0xf, 0xf, false));
}
struct EpiUp {
    static constexpr bool PERM = true, ROWPERM = true;
    bf16_t* act; const float* cw; const float* cb; float* topa; float* topv; float* bota;
    __device__ __forceinline__ void operator()(const f32x4 (&acc)[2][2][4][2], const Unit& u, int wr, int wc, int fr, int fq, LAS unsigned char* xl, int) const {
        const int jt = u.pm & 15;
        const int f0 = u.pn * 128 + wc * 32 + 8 * fq;
        if (fr == 15) {
#pragma unroll
            for (int ai = 0; ai < 2; ++ai) { LAS f32x4* p = (LAS f32x4*)(xl + ((ai * 2 + wr) * 4 + wc) * 256 + fq * 64); p[0] = acc[ai][0][2][0]; p[1] = acc[ai][0][2][1]; p[2] = acc[ai][0][3][0]; p[3] = acc[ai][0][3][1]; }
        }
        LDS_WAIT(); __builtin_amdgcn_s_barrier(); asm volatile("" ::: "memory");
        f32x4 h2[2][2], h3[2][2];
#pragma unroll
        for (int ai = 0; ai < 2; ++ai) {
            const int sa = wr ? ai : 0, sw = wr ? 0 : 1;
            const LAS f32x4* p = (const LAS f32x4*)(xl + ((sa * 2 + sw) * 4 + wc) * 256 + fq * 64);
            const bool none = (ai == 0) && (wr == 0);
#pragma unroll
            for (int n = 0; n < 2; ++n) { h2[ai][n] = none ? (f32x4){0.f, 0.f, 0.f, 0.f} : p[n]; h3[ai][n] = none ? (f32x4){0.f, 0.f, 0.f, 0.f} : p[2 + n]; }
        }
        f32x4 w0[2], w1[2], w2[2], bb[2];
#pragma unroll
        for (int n = 0; n < 2; ++n) { w0[n] = *(const GAS f32x4*)(cw + f0 + 4 * n); w1[n] = *(const GAS f32x4*)(cw + FF + f0 + 4 * n); w2[n] = *(const GAS f32x4*)(cw + 2 * FF + f0 + 4 * n); bb[n] = *(const GAS f32x4*)(cb + f0 + 4 * n); }
        LDS_WAIT();
#pragma unroll
        for (int ai = 0; ai < 2; ++ai) {
            f32x4 s2[2], s3[2];
#pragma unroll
            for (int n = 0; n < 2; ++n)
#pragma unroll
                for (int j = 0; j < 4; ++j) { s3[n][j] = dpp_prev1(acc[ai][0][3][n][j], h3[ai][n][j]); s2[n][j] = dpp_prev1(acc[ai][0][2][n][j], h2[ai][n][j]); }
#pragma unroll
            for (int m = 0; m < 4; ++m) {
                const int r = ai * HALF + wr * 64 + 4 * fr + m;
                f32x4 o[2];
#pragma unroll
                for (int n = 0; n < 2; ++n) {
                    const f32x4 c = acc[ai][0][m][n];
                    const f32x4 x1 = (m == 0) ? s3[n] : acc[ai][0][m > 0 ? m - 1 : 0][n];
                    const f32x4 x2 = (m == 0) ? s2[n] : (m == 1) ? s3[n] : acc[ai][0][m > 1 ? m - 2 : 0][n];
                    const f32x4 a = __builtin_elementwise_fma(x2, w0[n], __builtin_elementwise_fma(x1, w1[n], __builtin_elementwise_fma(c, w2[n], bb[n])));
                    const f32x2 g0 = gelu_pk((f32x2){a[0], a[1]}), g1 = gelu_pk((f32x2){a[2], a[3]});
                    const f32x4 v = acc[ai][1][m][n];
                    const f32x2 r0 = g0 * (f32x2){v[0], v[1]}, r1 = g1 * (f32x2){v[2], v[3]};
                    o[n] = (f32x4){r0.x, r0.y, r1.x, r1.y};
                }
                u32x4 w; w.x = cvt_pk_bf16(o[0][0], o[0][1]); w.y = cvt_pk_bf16(o[0][2], o[0][3]); w.z = cvt_pk_bf16(o[1][0], o[1][1]); w.w = cvt_pk_bf16(o[1][2], o[1][3]);
                const bool deferred = (ai == 0 && m < 2) && (wr == 0 && jt > 0 && fr == 0);
                if (!deferred) *(GAS u32x4*)(act + (size_t)(u.pm * BM + r) * FF + f0) = w;
                if (ai == 0 && m < 2) { if (wr == 0 && jt > 0 && fr == 0) { float* pa = topa + (size_t)(u.pm * 2 + m) * FF + f0; float* pv = topv + (size_t)(u.pm * 2 + m) * FF + f0;
                        *(GAS f32x4*)pa = acc[0][0][m][0]; *(GAS f32x4*)(pa + 4) = acc[0][0][m][1]; *(GAS f32x4*)pv = acc[0][1][m][0]; *(GAS f32x4*)(pv + 4) = acc[0][1][m][1]; } }
                if (ai == 1 && m >= 2) { if (wr == 1 && fr == 15) { float* pb = bota + (size_t)(u.pm * 2 + (m - 2)) * FF + f0; *(GAS f32x4*)pb = acc[1][0][m][0]; *(GAS f32x4*)(pb + 4) = acc[1][0][m][1]; } }
            }
        }
    }
};

template <class Epi, int MODE>
__device__ __forceinline__ void gemm_phase(LAS unsigned char* lds, LAS unsigned char* xl, const Gemm g, const Order& S, const Epi& E, const int tid) {
    const int wid = __builtin_amdgcn_readfirstlane(tid >> 6), lane = tid & 63, wr = wid >> 2, wc = wid & 3, fr = lane & 15, fq = lane >> 4;
    const int K = g.K, nt = K / BK, lda = g.lda;
    unsigned voffA[2], voffB[2];
#pragma unroll
    for (int i = 0; i < 2; ++i) { int R, C; stage_rc(tid * 16 + i * 8192, R, C); const int Rb = Epi::PERM ? ((R & ~31) + perm32(R & 31)) : R;
        const int Ra = Epi::ROWPERM ? ((R & 64) | ((R & 15) << 2) | ((R >> 4) & 3)) : R;
        voffA[i] = (unsigned)(Ra * lda + C) * 2u; voffB[i] = (unsigned)(Rb * K + C) * 2u; }
    const size_t kstep = (size_t)(BK * 2);
    const size_t hstepA = (size_t)HALF * lda * 2, hstepB = (size_t)HALF * K * 2;
    const size_t tstepB = 2 * hstepB;
    const unsigned ldsw = (unsigned)wid * 1024u, ldsbase = (unsigned)(uintptr_t)lds;
    const int aoff = lds_byte(wr * 64 + fr, fq * 8), boff = lds_byte(wc * 32 + fr, fq * 8);
#define PG8_SA(b, h) (((b) * 2 + (h)) * HTB)
#define PG8_SB(b, h) ((4 + (b) * 2 + (h)) * HTB)
#define PG8_STAGE(bufoff, gbase, voff) do { _Pragma("unroll") for (int _i = 0; _i < 2; ++_i) { unsigned _keep; \
        asm volatile("s_mov_b32 %0, m0\n\ts_mov_b32 m0, %3\n\ts_nop 0\n\tglobal_load_lds_dwordx4 %1, %2\n\ts_mov_b32 m0, %0" : "=&s"(_keep) : "v"((voff)[_i]), "s"((const char*)(gbase)), "s"(ldsbase + (unsigned)(bufoff) + ldsw + (unsigned)(_i * 8192)) : "memory"); } } while (0)
#define PG8_LDA(dst, b, h) do { _Pragma("unroll") for (int m = 0; m < 4; ++m) _Pragma("unroll") for (int k = 0; k < 2; ++k) dst[m][k] = *(const LAS bf16x8*)(lds + PG8_SA(b, h) + aoff + m * 2048 + k * 1024); } while (0)
#define PG8_LDB(dst, b, h) do { _Pragma("unroll") for (int n = 0; n < 2; ++n) _Pragma("unroll") for (int k = 0; k < 2; ++k) dst[n][k] = *(const LAS bf16x8*)(lds + PG8_SB(b, h) + boff + n * 2048 + k * 1024); } while (0)
#define PG8_MMA(ai, bj, At, Bt) do { __builtin_amdgcn_s_setprio(1); _Pragma("unroll") for (int m = 0; m < 4; ++m) _Pragma("unroll") for (int n = 0; n < 2; ++n) _Pragma("unroll") for (int k = 0; k < 2; ++k) \
        acc[ai][bj][m][n] = __builtin_amdgcn_mfma_f32_16x16x32_bf16(Bt[n][k], At[m][k], acc[ai][bj][m][n], 0, 0, 0); __builtin_amdgcn_s_setprio(0); } while (0)
#define PG8_WAIT_V(n) asm volatile("s_waitcnt vmcnt(" #n ")" ::: "memory")
#define PG8_WAIT_L(n) asm volatile("s_waitcnt lgkmcnt(" #n ")" ::: "memory")
#define PG8_BAR __builtin_amdgcn_s_barrier()
#define PG8_SCHED __builtin_amdgcn_sched_barrier(0)
    Unit cur, nxt; int ui = 0;
    if (!S.next(0, cur)) return;
    f32x4 acc[2][2][4][2];
#pragma unroll
    for (int a = 0; a < 2; ++a)
#pragma unroll
        for (int b = 0; b < 2; ++b)
#pragma unroll
            for (int m = 0; m < 4; ++m)
#pragma unroll
                for (int n = 0; n < 2; ++n) acc[a][b][m][n] = (f32x4){0.f, 0.f, 0.f, 0.f};
    bf16x8 At[4][2], B0[2][2], B1[2][2];
    const char* cA = (const char*)g.A + a_off<MODE>(g, cur); const char* cB = (const char*)g.Bt + (size_t)cur.pn * tstepB;
    PG8_STAGE(PG8_SB(0, 0), cB, voffB); PG8_STAGE(PG8_SB(0, 1), cB + hstepB, voffB); PG8_STAGE(PG8_SA(0, 0), cA, voffA); PG8_STAGE(PG8_SA(0, 1), cA + hstepA, voffA);
    if (wr == 1) PG8_BAR;
    PG8_WAIT_V(2); PG8_BAR;
    PG8_STAGE(PG8_SB(1, 0), cB + kstep, voffB); PG8_STAGE(PG8_SA(1, 0), cA + kstep, voffA); PG8_STAGE(PG8_SB(1, 1), cB + hstepB + kstep, voffB);
    PG8_WAIT_V(6); PG8_BAR;
    for (;;) {
        const bool has_next = S.next(ui + 1, nxt);
        const char* nA = has_next ? (const char*)g.A + a_off<MODE>(g, nxt) : cA; const char* nB = has_next ? (const char*)g.Bt + (size_t)nxt.pn * tstepB : cB;
        for (int t = 0; t < nt; t += 2) {
            const bool last = (t == nt - 2);
            const char* a1 = cA + (size_t)(t + 1) * kstep;
            const char* a2 = last ? nA : cA + (size_t)(t + 2) * kstep; const char* b2 = last ? nB : cB + (size_t)(t + 2) * kstep;
            const char* a3 = a2 + kstep; const char* b3 = b2 + kstep;
            PG8_LDB(B0, 0, 0); PG8_LDB(B1, 0, 1); PG8_SCHED; PG8_LDA(At, 0, 0); PG8_STAGE(PG8_SA(1, 1), a1 + hstepA, voffA);
            PG8_WAIT_V(8); PG8_WAIT_L(0); PG8_BAR; PG8_MMA(0, 0, At, B0); PG8_MMA(0, 1, At, B1); PG8_BAR; PG8_SCHED;
            PG8_LDA(At, 0, 1); PG8_STAGE(PG8_SB(0, 0), b2, voffB); PG8_STAGE(PG8_SB(0, 1), b2 + hstepB, voffB); PG8_STAGE(PG8_SA(0, 0), a2, voffA);
            PG8_WAIT_V(8); PG8_WAIT_L(0); PG8_BAR; PG8_MMA(1, 0, At, B0); PG8_MMA(1, 1, At, B1); PG8_BAR; PG8_SCHED;
            PG8_LDB(B0, 1, 0); PG8_LDB(B1, 1, 1); PG8_SCHED; PG8_LDA(At, 1, 0); PG8_STAGE(PG8_SA(0, 1), a2 + hstepA, voffA);
            PG8_WAIT_V(8); PG8_WAIT_L(0); PG8_BAR; PG8_MMA(0, 0, At, B0); PG8_MMA(0, 1, At, B1); PG8_BAR; PG8_SCHED;
            PG8_LDA(At, 1, 1); PG8_STAGE(PG8_SB(1, 0), b3, voffB); PG8_STAGE(PG8_SB(1, 1), b3 + hstepB, voffB); PG8_STAGE(PG8_SA(1, 0), a3, voffA);
            PG8_WAIT_V(8); PG8_WAIT_L(0); PG8_BAR; PG8_MMA(1, 0, At, B0); PG8_MMA(1, 1, At, B1); PG8_BAR; PG8_SCHED;
        }
        if (wr == 0) PG8_BAR;
        { int l2; asm volatile("v_mbcnt_lo_u32_b32 %0, -1, 0\n\tv_mbcnt_hi_u32_b32 %0, -1, %0" : "=v"(l2));
          E(acc, cur, wr, wc, l2 & 15, l2 >> 4, xl, l2); }
        if (!has_next) break;
#pragma unroll
        for (int a = 0; a < 2; ++a)
#pragma unroll
            for (int b = 0; b < 2; ++b)
#pragma unroll
                for (int m = 0; m < 4; ++m)
#pragma unroll
                    for (int n = 0; n < 2; ++n) acc[a][b][m][n] = (f32x4){0.f, 0.f, 0.f, 0.f};
        cur = nxt; cA = nA; cB = nB; ++ui;
        if (wr == 1) PG8_BAR;
    }
    PG8_WAIT_V(0);
    PG8_BAR;
#undef PG8_SA
#undef PG8_SB
#undef PG8_STAGE
#undef PG8_LDA
#undef PG8_LDB
#undef PG8_MMA
#undef PG8_WAIT_V
#undef PG8_WAIT_L
#undef PG8_BAR
#undef PG8_SCHED
}
}

namespace att {
constexpr int NW = 8, QBLK = 32, KVBLK = 64, QB = 256;
constexpr int QP = 1536, KP = 2048, KRP = 64, VP = 2048, OP = 1024;
constexpr int KROWB = 272, KRROWB = 144;
constexpr int SHM_V = 16384, SHM_K = 64 * KROWB, SHM_KR = 64 * KRROWB;
constexpr int OFF_V = 0, OFF_K = 2 * SHM_V, OFF_KR = OFF_K + 2 * SHM_K, OFF_WS = OFF_KR + 2 * SHM_KR, OFF_QR = OFF_WS + NW * 256, NQREG = 8, NQLDS = 12 - NQREG, ATT_LDS = OFF_QR + NW * NQLDS * 1024;
static_assert(ATT_LDS <= LDS_BYTES, "attention LDS");
constexpr float SCALE = 0.07216878364870323f;
constexpr float THR = 8.f;
#define KSWZ(row, colB) ((row) * KROWB + (colB))
#define KRSWZ(row, colB) ((row) * KRROWB + (colB))
#define SBAR() __builtin_amdgcn_sched_barrier(0)
__device__ __forceinline__ int v_st(int k, int c) { const int kk = (k & ~0xC) | ((k & 4) << 1) | ((k & 8) >> 1); return ((kk >> 3) * 4 + (c >> 5)) * 512 + ((kk & 7) * 32 + (c & 31)) * 2; }
__device__ __forceinline__ int v_rd_base(int lane) { return ((lane & 3) << 3) | (((lane >> 2) & 3) << 6) | (((lane >> 4) & 1) << 5) | (((lane >> 5) & 1) << 8); }
constexpr int v_rd_off(int d0, int ks, int half) { return d0 * 512 + ks * 4096 + half * 2048; }
__device__ __forceinline__ int crow(int r, int hi) { return (r & 3) + 8 * (r >> 2) + 4 * hi; }
__device__ __forceinline__ bf16x8 ld8(const bf16_t* p) { return *reinterpret_cast<const bf16x8*>(p); }
__device__ __forceinline__ void mask_tile(f32x16& p0, f32x16& p1, int dq) {
    const float NEG = -__builtin_inff();
#pragma unroll
    for (int r = 0; r < 16; ++r) {
        const int c = (r & 3) + 8 * (r >> 2);
        if (dq - c < 0) p0[r] = NEG;
        if (dq - c - 32 < 0) p1[r] = NEG;
    }
}
__device__ __forceinline__ void partialSM(f32x16& p0, f32x16& p1, float& m_reg, float& mn, float& alpha) {
    float pmax = p0[0];
#pragma unroll
    for (int r = 1; r < 16; ++r) pmax = fmaxf(pmax, p0[r]);
#pragma unroll
    for (int r = 0; r < 16; ++r) pmax = fmaxf(pmax, p1[r]);
    { unsigned r0, r1; swap32_self(__float_as_uint(pmax), r0, r1); pmax = fmaxf(__uint_as_float(r0), __uint_as_float(r1)); }
    constexpr float C2 = 1.4426950408889634f * SCALE;
    if (__builtin_expect(__all((pmax - m_reg) * SCALE <= THR), 1)) { mn = m_reg; alpha = 1.f; }
    else { mn = fmaxf(m_reg, pmax); alpha = __builtin_amdgcn_exp2f((m_reg - mn) * C2); m_reg = mn; }
    const float mnL = -mn * C2;
#pragma unroll
    for (int r = 0; r < 16; ++r) p0[r] = fmaf(p0[r], C2, mnL);
#pragma unroll
    for (int r = 0; r < 16; ++r) p1[r] = fmaf(p1[r], C2, mnL);
#pragma unroll
    for (int r = 0; r < 16; ++r) p0[r] = __builtin_amdgcn_exp2f(p0[r]);
}
__device__ __forceinline__ void finishSM(f32x16& p0, f32x16& p1, float alpha, float& l_reg, bf16x8& pa0, bf16x8& pa1, bf16x8& pa2, bf16x8& pa3) {
#pragma unroll
    for (int r = 0; r < 16; ++r) p1[r] = __builtin_amdgcn_exp2f(p1[r]);
    float ps = 0;
#pragma unroll
    for (int r = 0; r < 16; ++r) ps += p0[r];
#pragma unroll
    for (int r = 0; r < 16; ++r) ps += p1[r];
    { unsigned r0, r1; swap32_self(__float_as_uint(ps), r0, r1); ps = __uint_as_float(r0) + __uint_as_float(r1); }
    l_reg = l_reg * alpha + ps;
#define PK4(P, B_, OUT) do { unsigned a0 = cvt_pk_bf16(P[B_+0], P[B_+1]), a1 = cvt_pk_bf16(P[B_+2], P[B_+3]);                          \
        unsigned b0 = cvt_pk_bf16(P[B_+4], P[B_+5]), b1 = cvt_pk_bf16(P[B_+6], P[B_+7]);                                             \
        auto r0 = __builtin_amdgcn_permlane32_swap(a0, b0, false, false); auto r1 = __builtin_amdgcn_permlane32_swap(a1, b1, false, false); \
        u32x4 w = {r0[0], r1[0], r0[1], r1[1]}; OUT = *reinterpret_cast<bf16x8*>(&w); } while (0)
    PK4(p0, 0, pa0); PK4(p0, 8, pa1); PK4(p1, 0, pa2); PK4(p1, 8, pa3);
#undef PK4
}
template <int KB>
__device__ __forceinline__ void qkt(f32x16& p0, f32x16& p1, const char* lds, int r32, int hi, const bf16x8* qr, const LAS char* qrl) {
    p0 = f32x16{}; p1 = f32x16{};
    const char* kb = lds + OFF_K + KB * SHM_K + KSWZ(r32, hi * 16); const char* kr = lds + OFF_KR + KB * SHM_KR + KRSWZ(r32, hi * 16);
#pragma unroll
    for (int d0 = 0; d0 < NQREG; ++d0) {
        bf16x8 b0 = *reinterpret_cast<const bf16x8*>(kb + d0 * 32);
        bf16x8 b1 = *reinterpret_cast<const bf16x8*>(kb + d0 * 32 + 32 * KROWB);
        p0 = __builtin_amdgcn_mfma_f32_32x32x16_bf16(b0, qr[d0], p0, 0, 0, 0);
        p1 = __builtin_amdgcn_mfma_f32_32x32x16_bf16(b1, qr[d0], p1, 0, 0, 0); }
#pragma unroll
    for (int d0 = NQREG; d0 < 8; ++d0) {
        bf16x8 b0 = *reinterpret_cast<const bf16x8*>(kb + d0 * 32);
        bf16x8 b1 = *reinterpret_cast<const bf16x8*>(kb + d0 * 32 + 32 * KROWB);
        const bf16x8 qf = *(const volatile LAS bf16x8*)(qrl + (d0 - NQREG) * 1024);
        p0 = __builtin_amdgcn_mfma_f32_32x32x16_bf16(b0, qf, p0, 0, 0, 0);
        p1 = __builtin_amdgcn_mfma_f32_32x32x16_bf16(b1, qf, p1, 0, 0, 0); }
#pragma unroll
    for (int dd = 0; dd < 4; ++dd) {
        bf16x8 b0 = *reinterpret_cast<const bf16x8*>(kr + dd * 32);
        bf16x8 b1 = *reinterpret_cast<const bf16x8*>(kr + dd * 32 + 32 * KRROWB);
        const bf16x8 qf = *(const volatile LAS bf16x8*)(qrl + (8 + dd - NQREG) * 1024);
        p0 = __builtin_amdgcn_mfma_f32_32x32x16_bf16(b0, qf, p0, 0, 0, 0);
        p1 = __builtin_amdgcn_mfma_f32_32x32x16_bf16(b1, qf, p1, 0, 0, 0); }
}
template <int VB>
__device__ __forceinline__ void pv_tile(f32x16* o, int vb0, bf16x8 pa0, bf16x8 pa1, bf16x8 pa2, bf16x8 pa3) {
#define TRRD(dst, off) asm volatile("ds_read_b64_tr_b16 %0, %1 offset:%2" : "=&v"(dst) : "v"(vb0), "i"(off) : "memory")
#define PV_D0(d0) do { s16x4 l0, l1, l2, l3, h0, h1, h2, h3; constexpr int b_ = OFF_V + VB * SHM_V + v_rd_off(d0, 0, 0); \
        TRRD(l0, b_); TRRD(h0, b_ + 2048); TRRD(l1, b_ + 4096); TRRD(h1, b_ + 6144); TRRD(l2, b_ + 8192); TRRD(h2, b_ + 10240); TRRD(l3, b_ + 12288); TRRD(h3, b_ + 14336); \
        asm volatile("s_waitcnt lgkmcnt(0)" ::: "memory"); SBAR();   \
        o[d0] = __builtin_amdgcn_mfma_f32_32x32x16_bf16(pa0, (bf16x8){l0[0], l0[1], l0[2], l0[3], h0[0], h0[1], h0[2], h0[3]}, o[d0], 0, 0, 0);   \
        o[d0] = __builtin_amdgcn_mfma_f32_32x32x16_bf16(pa1, (bf16x8){l1[0], l1[1], l1[2], l1[3], h1[0], h1[1], h1[2], h1[3]}, o[d0], 0, 0, 0);   \
        o[d0] = __builtin_amdgcn_mfma_f32_32x32x16_bf16(pa2, (bf16x8){l2[0], l2[1], l2[2], l2[3], h2[0], h2[1], h2[2], h2[3]}, o[d0], 0, 0, 0);   \
        o[d0] = __builtin_amdgcn_mfma_f32_32x32x16_bf16(pa3, (bf16x8){l3[0], l3[1], l3[2], l3[3], h3[0], h3[1], h3[2], h3[3]}, o[d0], 0, 0, 0); } while (0)
    PV_D0(0); PV_D0(1); PV_D0(2); PV_D0(3);
#undef PV_D0
#undef TRRD
}
struct BlockRef { const bf16_t* Q; const bf16_t* K; const bf16_t* KR; const bf16_t* V; bf16_t* O; int P0; };
#define VMW() asm volatile("s_waitcnt vmcnt(0)" ::: "memory")
#define GLD8(base, soff, voff) (*(const __attribute__((address_space(1))) bf16x8*)((const __attribute__((address_space(1))) char*)(base) + (size_t)(soff) + (voff)))
#define LOADK(k0) do { st_k0 = GLD8(cur.K, (size_t)(k0) * (KP * 2), kvoff); st_k1 = GLD8(cur.K, (size_t)((k0) + 32) * (KP * 2), kvoff);   \
                       st_kr = GLD8(cur.KR, (size_t)(k0) * (KRP * 2), krvoff); } while (0)
#define LOADV(k0) do { st_v0 = GLD8(cur.V, (size_t)(k0) * (VP * 2), kvoff); st_v1 = GLD8(cur.V, (size_t)((k0) + 32) * (VP * 2), kvoff); } while (0)
#define WRITEK(bf) do { *(bf16x8*)(lds + OFF_K + (bf) * SHM_K + kws) = st_k0; *(bf16x8*)(lds + OFF_K + (bf) * SHM_K + kws + 32 * KROWB) = st_k1; \
                        *(bf16x8*)(lds + OFF_KR + (bf) * SHM_KR + krws) = st_kr; } while (0)
#define WRITEV(bf) do { *(bf16x8*)(lds + OFF_V + (bf) * SHM_V + vst0) = st_v0; *(bf16x8*)(lds + OFF_V + (bf) * SHM_V + vst1) = st_v1; } while (0)
#define ABAR() do { asm volatile("s_waitcnt lgkmcnt(0)" ::: "memory"); __builtin_amdgcn_s_barrier(); asm volatile("" ::: "memory"); } while (0)
__device__ __forceinline__ void block(const BlockRef& cur, char* lds, const int tid) {
    const int wid = __builtin_amdgcn_readfirstlane(tid >> 6), lane = tid & 63, r32 = lane & 31, hi = lane >> 5, grp = wid >> 2;
    const int NT = (cur.P0 + QB) / KVBLK;
    const int qlo = cur.P0 + wid * QBLK, qm = qlo + r32 - 4 * hi;
    float* ws = (float*)(lds + OFF_WS) + wid * 64; float* li_l = ws, * al_l = ws + 32;
    float m_reg = -1e30f, l_reg = 0; f32x16 o[4] = {};
    const int sr = tid >> 4, sc = (tid & 15) * 8, vst0 = v_st(sr, sc), vst1 = v_st(32 + sr, sc), kws = KSWZ(sr, sc * 2);
    const int krr = tid >> 3, krc = (tid & 7) * 8, krws = KRSWZ(krr, krc * 2);
    const unsigned kvoff = (unsigned)(sr * KP + sc) * 2u, krvoff = (unsigned)(krr * KRP + krc) * 2u, qvoff = (unsigned)((wid * QBLK + r32) * QP + hi * 8) * 2u;
    const int vb0 = (int)(uintptr_t)lds + v_rd_base(lane);
    LAS char* qrl = (LAS char*)lds + OFF_QR + wid * (NQLDS * 1024) + lane * 16;
    bf16x8 qr[NQREG]; bf16x8 st_v0, st_v1, st_k0, st_k1, st_kr;
#pragma unroll
    for (int d0 = 0; d0 < NQREG; ++d0) qr[d0] = GLD8(cur.Q, d0 * 32, qvoff);
#pragma unroll
    for (int dd = 0; dd < NQLDS; ++dd) { const bf16x8 tq = GLD8(cur.Q, (NQREG + dd) * 32, qvoff); *(volatile LAS bf16x8*)(qrl + dd * 1024) = tq; }
    LOADK(0); VMW(); WRITEK(0);
    LOADK(KVBLK); LOADV(0);
    ABAR();
    if (grp) ABAR();
#define RESC(a) do { if (__any((a) < 1.f)) { if (hi == 0) al_l[r32] = (a); asm volatile("s_waitcnt lgkmcnt(0)" ::: "memory");              \
                     for (int d_ = 0; d_ < 4; ++d_) for (int r = 0; r < 16; ++r) o[d_][r] *= al_l[crow(r, hi)]; } } while (0)
#define KBASE(t) ((t) * KVBLK)
#define MASKT(P0_, P1_, t) do { const int kb_ = KBASE(t); if (kb_ + KVBLK - 1 > qlo) mask_tile(P0_, P1_, qm - kb_); } while (0)
    f32x16 p0, p1; bf16x8 pa0, pa1, pa2, pa3;
#define STEP(t, KB) do { float mn, al;                                                                                         \
        VMW(); if ((t) + 1 < NT) WRITEK((KB) ^ 1); WRITEV(KB);                                                                 \
        if ((t) + 2 < NT) LOADK(KBASE((t) + 2)); if ((t) + 1 < NT) LOADV(KBASE((t) + 1));                                      \
        SBAR(); qkt<KB>(p0, p1, lds, r32, hi, qr, qrl);                                                                        \
        if ((t) > 0) pv_tile<(KB) ^ 1>(o, vb0, pa0, pa1, pa2, pa3);                                                            \
        ABAR();                                                                                                                \
        MASKT(p0, p1, (t)); partialSM(p0, p1, m_reg, mn, al); RESC(al);                                                        \
        finishSM(p0, p1, al, l_reg, pa0, pa1, pa2, pa3);                                                                       \
        ABAR(); } while (0)
    for (int t = 0; t < NT; t += 2) { STEP(t, 0); STEP(t + 1, 1); }
    pv_tile<1>(o, vb0, pa0, pa1, pa2, pa3);
    if (!grp) ABAR();
    if (hi == 0) li_l[r32] = l_reg; asm volatile("s_waitcnt lgkmcnt(0)" ::: "memory");
    float rli[16];
#pragma unroll
    for (int r = 0; r < 16; ++r) rli[r] = __builtin_amdgcn_rcpf(li_l[crow(r, hi)]);
    bf16_t* Ow = cur.O + (size_t)(wid * QBLK) * OP;
#pragma unroll
    for (int r = 0; r < 16; ++r) { const int orow = crow(r, hi);
#pragma unroll
        for (int d0 = 0; d0 < 4; ++d0) { const float v = o[d0][r] * rli[r];
            const float vn = DPPF(v, 0xB1);
            if ((r32 & 1) == 0) *(unsigned*)(Ow + (size_t)orow * OP + d0 * 32 + r32) = cvt_pk_bf16(v, vn); } }
    ABAR();
#undef RESC
#undef KBASE
#undef MASKT
#undef STEP
}
#undef LOADK
#undef LOADV
#undef WRITEK
#undef WRITEV
#undef GLD8
__device__ __forceinline__ BlockRef mkref(int bh, int qb, const bf16_t* Q, const bf16_t* KV, const bf16_t* KR, bf16_t* O) {
    const int b = bh >> 3, h = bh & 7; BlockRef r;
    r.Q = Q + (size_t)(b * SEQ + qb * QB) * QP + h * 192; r.K = KV + (size_t)b * SEQ * KP + h * 128; r.KR = KR + (size_t)b * SEQ * KRP;
    r.V = KV + (size_t)b * SEQ * VP + 1024 + h * 128; r.O = O + (size_t)(b * SEQ + qb * QB) * OP + h * 128; r.P0 = qb * QB; return r;
}
__device__ __forceinline__ void attn_phase(char* lds, const bf16_t* Q, const bf16_t* KV, const bf16_t* KR, bf16_t* O, const int tid, const int bid) {
    for (int L = bid; L < 512; L += gridDim.x) {
        const int bh = (L >> 6) * 8 + (L & 7), x = (L >> 3) & 7;
        for (int pass = 0; pass < 2; ++pass) { const BlockRef cur = mkref(bh, pass ? x : 15 - x, Q, KV, KR, O); block(cur, lds, tid); }
    }
}
}

__device__ __forceinline__ void norm_rows(const float* x, const float* g1, const float* mods_l, int shi, int sci, bf16_t* o1, const float* g2, bf16_t* o2, int gw, int NGW, int lane) {
    f32x4 nx[4];
    if (gw < MT) { const f32x4* xr = (const f32x4*)(x + (size_t)gw * DM) + lane;
#pragma unroll
        for (int j = 0; j < 4; ++j) nx[j] = xr[64 * j]; }
    for (int m = gw; m < MT; m += NGW) {
        const int b = m >> 12;
        f32x4 v[4]; float s = 0.f;
#pragma unroll
        for (int j = 0; j < 4; ++j) v[j] = nx[j];
        if (m + NGW < MT) { const f32x4* xr = (const f32x4*)(x + (size_t)(m + NGW) * DM) + lane;
#pragma unroll
            for (int j = 0; j < 4; ++j) nx[j] = xr[64 * j]; }
#pragma unroll
        for (int j = 0; j < 4; ++j) s += (v[j].x * v[j].x + v[j].y * v[j].y) + (v[j].z * v[j].z + v[j].w * v[j].w);
        const float rstd = rsqrtf(wave_sum(s) * (1.f / DM) + EPS);
#pragma unroll
        for (int j = 0; j < 4; ++j) { const int col = 4 * lane + 256 * j; const f32x4 y = v[j] * rstd;
            f32x4 h = y * *(const f32x4*)(g1 + col);
            if (mods_l) { const f32x4 scv = *(const f32x4*)(mods_l + b * 6144 + sci * 1024 + col), shv = *(const f32x4*)(mods_l + b * 6144 + shi * 1024 + col); h = h * (scv + 1.0f) + shv; }
            u32x2 w; w.x = pk2(h.x, h.y); w.y = pk2(h.z, h.w); *(u32x2*)(o1 + (size_t)m * DM + col) = w;
            if (o2) { const f32x4 k = y * *(const f32x4*)(g2 + col); u32x2 w2; w2.x = pk2(k.x, k.y); w2.y = pk2(k.z, k.w); *(u32x2*)(o2 + (size_t)m * DM + col) = w2; } }
    }
}
__device__ __forceinline__ void norm_rows_b(const bf16_t* x, const float* g1, const float* mods_l, int shi, int sci, bf16_t* o1, const float* g2, bf16_t* o2, int gw, int NGW, int lane) {
    u32x4 nx[2];
    if (gw < MT) { const u32x4* xr = (const u32x4*)(x + (size_t)gw * DM) + lane; nx[0] = xr[0]; nx[1] = xr[64]; }
    for (int m = gw; m < MT; m += NGW) {
        const int b = m >> 12;
        u32x4 raw[2] = {nx[0], nx[1]};
        if (m + NGW < MT) { const u32x4* xr = (const u32x4*)(x + (size_t)(m + NGW) * DM) + lane; nx[0] = xr[0]; nx[1] = xr[64]; }
        float v[2][8]; float s = 0.f;
#pragma unroll
        for (int j = 0; j < 2; ++j)
#pragma unroll
            for (int q = 0; q < 4; ++q) { v[j][2 * q] = bflo(raw[j][q]); v[j][2 * q + 1] = bfhi(raw[j][q]); s += v[j][2 * q] * v[j][2 * q] + v[j][2 * q + 1] * v[j][2 * q + 1]; }
        const float rstd = rsqrtf(wave_sum(s) * (1.f / DM) + EPS);
#pragma unroll
        for (int j = 0; j < 2; ++j) { const int col = 8 * lane + 512 * j;
            const f32x4 ga = *(const f32x4*)(g1 + col), gb = *(const f32x4*)(g1 + col + 4);
            f32x4 ya = (f32x4){v[j][0], v[j][1], v[j][2], v[j][3]} * rstd, yb = (f32x4){v[j][4], v[j][5], v[j][6], v[j][7]} * rstd;
            f32x4 ha = ya * ga, hb = yb * gb;
            if (mods_l) { const float* sp = mods_l + b * 6144 + sci * 1024 + col; const float* hp = mods_l + b * 6144 + shi * 1024 + col;
                ha = ha * (*(const f32x4*)sp + 1.0f) + *(const f32x4*)hp; hb = hb * (*(const f32x4*)(sp + 4) + 1.0f) + *(const f32x4*)(hp + 4); }
            u32x4 w; w.x = pk2(ha.x, ha.y); w.y = pk2(ha.z, ha.w); w.z = pk2(hb.x, hb.y); w.w = pk2(hb.z, hb.w); *(u32x4*)(o1 + (size_t)m * DM + col) = w;
            if (o2) { const f32x4 ka = ya * *(const f32x4*)(g2 + col), kb = yb * *(const f32x4*)(g2 + col + 4);
                u32x4 w2; w2.x = pk2(ka.x, ka.y); w2.y = pk2(ka.z, ka.w); w2.z = pk2(kb.x, kb.y); w2.w = pk2(kb.z, kb.w); *(u32x4*)(o2 + (size_t)m * DM + col) = w2; } }
    }
}
__device__ __forceinline__ void ld8f(const bf16_t* p, float* v) { const u32x4 u = *(const u32x4*)p;
#pragma unroll
    for (int q = 0; q < 4; ++q) { v[2 * q] = bflo(u[q]); v[2 * q + 1] = bfhi(u[q]); } }
__device__ __forceinline__ void pooled_phase(const bf16_t* h, bf16_t* out, int gtid, int NT_) {
    for (int job = gtid; job < (MT / 32) * 128; job += NT_) {
        const int col = (job & 127) * 8, row0 = (job >> 7) * 32, w = 2 << (col >> 8), t0 = row0 & (SEQ - 1);
        const bf16_t* hp = h + (size_t)row0 * DM + col; bf16_t* op = out + (size_t)row0 * DM + col;
        float s[8];
#pragma unroll
        for (int q = 0; q < 8; ++q) s[q] = 0.f;
        const int nwarm = (t0 < w) ? t0 : w;
        for (int k = 1; k <= nwarm; ++k) { float v[8]; ld8f(hp - (size_t)k * DM, v);
#pragma unroll
            for (int q = 0; q < 8; ++q) s[q] += v[q]; }
#pragma unroll 4
        for (int r = 0; r < 32; ++r) { const int t = t0 + r; float cur[8]; ld8f(hp + (size_t)r * DM, cur);
#pragma unroll
            for (int q = 0; q < 8; ++q) s[q] += cur[q];
            if (t >= w) { float old[8]; ld8f(hp + (size_t)(r - w) * DM, old);
#pragma unroll
                for (int q = 0; q < 8; ++q) s[q] -= old[q]; }
            const float inv = 1.0f / (float)((t + 1 < w) ? t + 1 : w);
            u32x4 o;
#pragma unroll
            for (int q = 0; q < 4; ++q) o[q] = pk2(s[2 * q] * inv - cur[2 * q], s[2 * q + 1] * inv - cur[2 * q + 1]);
            *(u32x4*)(op + (size_t)r * DM) = o; }
    }
}
__device__ __forceinline__ void cq_norm(const bf16_t* raw, const float* g, bf16_t* out, int gw, int NGW, int lane) {
    u32x2 na = {0u, 0u}, nc = {0u, 0u};
    if (gw < MT) { const bf16_t* r = raw + (size_t)gw * 512; na = *(const u32x2*)(r + 4 * lane); if (lane < 32) nc = *(const u32x2*)(r + 256 + 4 * lane); }
    for (int m = gw; m < MT; m += NGW) {
        const u32x2 a = na, c = nc;
        if (m + NGW < MT) { const bf16_t* r = raw + (size_t)(m + NGW) * 512; na = *(const u32x2*)(r + 4 * lane); if (lane < 32) nc = *(const u32x2*)(r + 256 + 4 * lane); }
        float v[8] = {bflo(a.x), bfhi(a.x), bflo(a.y), bfhi(a.y), bflo(c.x), bfhi(c.x), bflo(c.y), bfhi(c.y)};
        float s = 0.f;
#pragma unroll
        for (int q = 0; q < 8; ++q) s += v[q] * v[q];
        const float rstd = rsqrtf(wave_sum(s) * (1.f / 384.f) + EPS);
        const f32x4 g0 = *(const f32x4*)(g + 4 * lane);
        u32x2 w; w.x = pk2(v[0] * rstd * g0.x, v[1] * rstd * g0.y); w.y = pk2(v[2] * rstd * g0.z, v[3] * rstd * g0.w);
        *(u32x2*)(out + (size_t)m * 384 + 4 * lane) = w;
        if (lane < 32) { const f32x4 g1 = *(const f32x4*)(g + 256 + 4 * lane); u32x2 w2; w2.x = pk2(v[4] * rstd * g1.x, v[5] * rstd * g1.y); w2.y = pk2(v[6] * rstd * g1.z, v[7] * rstd * g1.w);
            *(u32x2*)(out + (size_t)m * 384 + 256 + 4 * lane) = w2; }
    }
}
__device__ __forceinline__ void ckv_norm(const bf16_t* raw, const float* g, const float* cs, bf16_t* ckv, bf16_t* kr, int gw, int NGW, int lane) {
    u32x2 na = {0u, 0u}; unsigned np = 0u; f32x2 ncs = {0.f, 0.f};
    if (gw < MT) { const bf16_t* r = raw + (size_t)gw * 512; na = *(const u32x2*)(r + 4 * lane); if (lane < 32) { np = *(const unsigned*)(r + 256 + 2 * lane); ncs = *(const f32x2*)(cs + (size_t)gw * 64 + 2 * lane); } }
    for (int m = gw; m < MT; m += NGW) {
        const u32x2 a = na; const unsigned p = np; const f32x2 c = ncs;
        if (m + NGW < MT) { const bf16_t* r = raw + (size_t)(m + NGW) * 512; na = *(const u32x2*)(r + 4 * lane); if (lane < 32) { np = *(const unsigned*)(r + 256 + 2 * lane); ncs = *(const f32x2*)(cs + (size_t)(m + NGW) * 64 + 2 * lane); } }
        const float v0 = bflo(a.x), v1 = bfhi(a.x), v2 = bflo(a.y), v3 = bfhi(a.y);
        const float rstd = rsqrtf(wave_sum(v0 * v0 + v1 * v1 + v2 * v2 + v3 * v3) * (1.f / 256.f) + EPS);
        const f32x4 g0 = *(const f32x4*)(g + 4 * lane);
        u32x2 w; w.x = pk2(v0 * rstd * g0.x, v1 * rstd * g0.y); w.y = pk2(v2 * rstd * g0.z, v3 * rstd * g0.w);
        *(u32x2*)(ckv + (size_t)m * 256 + 4 * lane) = w;
        if (lane < 32) { const float x1 = bflo(p), x2 = bfhi(p);
            *(unsigned*)(kr + (size_t)m * 64 + 2 * lane) = pk2(x1 * c.x - x2 * c.y, x2 * c.x + x1 * c.y); }
    }
}
__device__ __forceinline__ int col_map(int kind, int n) {
    if (kind == 0) return n;
    if (kind == 1) { const int pn = n >> 8, r = n & 255; return (r >> 7) * FF + 128 * pn + (r & 127); }
    if (kind == 2) { if (n < 256) return n; if (n < 320) { const int i = n - 256; return 256 + (i >> 1) + (i & 1) * 32; } return -1; }
    if (kind == 3) { const int h = n / 192, r = n - h * 192; if (r < 128) return n; const int i = r - 128; return h * 192 + 128 + (i >> 1) + (i & 1) * 32; }
    return n < 384 ? n : -1;
}
__device__ __forceinline__ void tr_item(const float* W, int K, int N, bf16_t* WT, int nblk, int kind, LAS float* scr, int item, int lane) {
    const int kb = item / nblk, nb = item - kb * nblk, k0 = 64 * kb, n0 = 32 * nb;
    const int src = col_map(kind, n0 + (lane & 31));
#pragma unroll
    for (int i = 0; i < 32; ++i) { const int kk = 2 * i + (lane >> 5); scr[kk * 33 + (lane & 31)] = src >= 0 ? W[(size_t)(k0 + kk) * N + src] : 0.f; }
    LDS_WAIT(); asm volatile("" ::: "memory");
    const int c = lane & 7;
#pragma unroll
    for (int j = 0; j < 4; ++j) { const int n = (lane >> 3) + 8 * j; const LAS float* s = scr + (8 * c) * 33 + n;
        u32x4 o; o.x = pk2(s[0 * 33], s[1 * 33]); o.y = pk2(s[2 * 33], s[3 * 33]); o.z = pk2(s[4 * 33], s[5 * 33]); o.w = pk2(s[6 * 33], s[7 * 33]);
        *(u32x4*)(WT + (size_t)(n0 + n) * K + k0 + 8 * c) = o; }
    LDS_WAIT(); asm volatile("" ::: "memory");
}
struct Seg { const float* W; bf16_t* WT; int K, N, Nout, kind; };
__device__ __forceinline__ Seg get_seg(ArgsP a, int s) {
    unsigned char* ws = a->ws; ASSUME_GLOBAL(ws); Seg g;
    if (s < 4) { g.W = AF(w_up) + (size_t)s * 1024 * 5632; g.WT = (bf16_t*)(ws + WS_WUP); g.K = 1024; g.N = 5632; g.Nout = 5632; g.kind = 1; }
    else if (s < 8) { const int l = s - 4; g.W = AF(w_down) + (size_t)l * FF * 1024; g.WT = (bf16_t*)(ws + WS_WDN); g.K = FF; g.N = 1024; g.Nout = 1024; g.kind = 0; }
    else if (s < 16) { const int i = s - 8; g.W = AF(pool_w) + (size_t)i * 65536; g.WT = (bf16_t*)(ws + WS_WPOOL) + (size_t)i * 65536; g.K = 256; g.N = 256; g.Nout = 256; g.kind = 0; }
    else if (s == 16) { g.W = AF(w_dkv); g.WT = (bf16_t*)(ws + WS_WDKV); g.K = 1024; g.N = 320; g.Nout = 512; g.kind = 2; }
    else if (s == 17) { g.W = AF(w_uk); g.WT = (bf16_t*)(ws + WS_WKV); g.K = 256; g.N = 1024; g.Nout = 1024; g.kind = 0; }
    else if (s == 18) { g.W = AF(w_uv); g.WT = (bf16_t*)(ws + WS_WKV) + (size_t)1024 * 256; g.K = 256; g.N = 1024; g.Nout = 1024; g.kind = 0; }
    else if (s < 21) { const int j = s - 19; g.W = AF(w_dq) + (size_t)j * 1024 * 384; g.WT = (bf16_t*)(ws + WS_WDQ) + (size_t)j * 512 * 1024; g.K = 1024; g.N = 384; g.Nout = 512; g.kind = 4; }
    else if (s < 23) { const int j = s - 21; g.W = AF(w_uq) + (size_t)j * 384 * 1536; g.WT = (bf16_t*)(ws + WS_WUQ + j * WUQ_SZ); g.K = 384; g.N = 1536; g.Nout = 1536; g.kind = 3; }
    else { const int j = s - 23; g.W = AF(w_o) + (size_t)j * 1024 * 1024; g.WT = (bf16_t*)(ws + WS_WO) + (size_t)j * 1024 * 1024; g.K = 1024; g.N = 1024; g.Nout = 1024; g.kind = 0; }
    return g;
}
constexpr int NSEG = 25;
__device__ __forceinline__ void prep_phase(ArgsP a, LAS unsigned char* lds, int tid, int lane, int wave, int bid) {
    unsigned char* wsp_ = a->ws; ASSUME_GLOBAL(wsp_); float* mods = (float*)(wsp_ + WS_MODS);
    LAS float* sl = (LAS float*)lds; LAS float* red = (LAS float*)(lds + 32768);
    for (int i = tid; i < NB * DM; i += NTHR) { const float v = AF(c)[i]; sl[i] = v / (1.f + __expf(-v)); }
    __syncthreads();
    for (int it = bid; it < 4 * 192; it += gridDim.x) {
        const int l = it / 192, e0 = (it - l * 192) * 32, c = lane & 31, kh = lane >> 5;
        const float* W = AF(mod_w) + (size_t)l * DM * 6144 + e0 + c;
        float acc[8];
#pragma unroll
        for (int b = 0; b < 8; ++b) acc[b] = 0.f;
        const int kbeg = wave * 128 + kh;
#pragma unroll 16
        for (int k = kbeg; k < kbeg + 128; k += 2) { const float wv = W[(size_t)k * 6144];
#pragma unroll
            for (int b = 0; b < 8; ++b) acc[b] += sl[b * DM + k] * wv; }
#pragma unroll
        for (int b = 0; b < 8; ++b) red[(wave * 8 + b) * 64 + lane] = acc[b];
        __syncthreads();
        if (tid < 256) { const int b = tid >> 5, cc = tid & 31; float s = AF(mod_b)[l * 6144 + e0 + cc];
#pragma unroll
          for (int w = 0; w < 8; ++w) s += red[(w * 8 + b) * 64 + cc] + red[(w * 8 + b) * 64 + 32 + cc];
          mods[(size_t)(l * 8 + b) * 6144 + e0 + cc] = s; }
        __syncthreads();
    }
    { float* cs = (float*)(wsp_ + WS_CS); const int gtid = bid * NTHR + tid, NT_ = gridDim.x * NTHR;
      for (int idx = gtid; idx < MT * 32; idx += NT_) { const int row = idx >> 5, i = idx & 31;
          const float inv = exp2f(-(float)i * 0.41524101186092029f);
          const double rev = (double)AI(pos)[row] * (double)inv * 0.15915494309189535; const float fr = (float)(rev - floor(rev));
          f32x2 o; o.x = __builtin_amdgcn_cosf(fr); o.y = __builtin_amdgcn_sinf(fr); *(f32x2*)(cs + (size_t)idx * 2) = o; } }
    __syncthreads();
    LAS float* scr = (LAS float*)(lds + wave * 16384);
    const int gw = bid * NWAVES + wave, NGW = gridDim.x * NWAVES;
    int base = 0;
    for (int s = 8; s < NSEG; ++s) {
        const Seg g = get_seg(a, s); const int nblk = g.Nout / 32, nit = (g.K / 64) * nblk;
        int first = (gw - base % NGW + NGW) % NGW;
        for (int it = first; it < nit; it += NGW) tr_item(g.W, g.K, g.N, g.WT, nblk, g.kind, scr, it, lane);
        base += nit;
    }
}
__device__ __forceinline__ void ffn_weights(ArgsP a, LAS unsigned char* lds, int l, int lane, int wave, int bid) {
    LAS float* scr = (LAS float*)(lds + wave * 16384);
    const int gw = bid * NWAVES + wave, NGW = gridDim.x * NWAVES;
    int base = 0;
    for (int q = 0; q < 2; ++q) {
        const Seg g = get_seg(a, q ? 4 + l : l); const int nblk = g.Nout / 32, nit = (g.K / 64) * nblk;
        int first = (gw - base % NGW + NGW) % NGW;
        for (int it = first; it < nit; it += NGW) tr_item(g.W, g.K, g.N, g.WT, nblk, g.kind, scr, it, lane);
        base += nit;
    }
}
__device__ __forceinline__ void final_norm(const bf16_t* x, float* out, const float* g, int gw, int NGW, int lane) {
    u32x4 nx[2];
    if (gw < MT) { const u32x4* xr = (const u32x4*)(x + (size_t)gw * DM) + lane; nx[0] = xr[0]; nx[1] = xr[64]; }
    for (int m = gw; m < MT; m += NGW) {
        u32x4 raw[2] = {nx[0], nx[1]};
        if (m + NGW < MT) { const u32x4* xr = (const u32x4*)(x + (size_t)(m + NGW) * DM) + lane; nx[0] = xr[0]; nx[1] = xr[64]; }
        float v[2][8]; float s = 0.f;
#pragma unroll
        for (int j = 0; j < 2; ++j)
#pragma unroll
            for (int q = 0; q < 4; ++q) { v[j][2 * q] = bflo(raw[j][q]); v[j][2 * q + 1] = bfhi(raw[j][q]); s += v[j][2 * q] * v[j][2 * q] + v[j][2 * q + 1] * v[j][2 * q + 1]; }
        const float rstd = rsqrtf(wave_sum(s) * (1.f / DM) + EPS);
#pragma unroll
        for (int j = 0; j < 2; ++j) { const int col = 8 * lane + 512 * j; float* o = out + (size_t)m * DM + col;
            *(f32x4*)o = (f32x4){v[j][0], v[j][1], v[j][2], v[j][3]} * rstd * *(const f32x4*)(g + col);
            *(f32x4*)(o + 4) = (f32x4){v[j][4], v[j][5], v[j][6], v[j][7]} * rstd * *(const f32x4*)(g + col + 4); }
    }
}


enum { K_PREP = 0, K_NORM1, K_POOLED, K_GPOOL, K_NORM2, K_GUP, K_GDOWN, K_NORMA, K_GEMMA, K_NORMB, K_GEMMB, K_ATTN, K_GWO, K_FINAL };
constexpr int NPHASE = 1 + 2 * 6 + 2 * 9 + 1;
__device__ __forceinline__ void phase_of(int ph, int& kind, int& l) {
    if (ph == 0) { kind = K_PREP; l = 0; return; }
    if (ph <= 12) { l = (ph - 1) / 6; const int k = (ph - 1) - l * 6; kind = (k == 0) ? K_NORM1 : (k == 1) ? K_POOLED : (k == 2) ? K_GPOOL : (k == 3) ? K_NORM2 : (k == 4) ? K_GUP : K_GDOWN; return; }
    if (ph <= 30) { const int q = (ph - 13) / 9, k = (ph - 13) - q * 9; l = 2 + q;
        kind = (k == 0) ? K_NORMA : (k == 1) ? K_GEMMA : (k == 2) ? K_NORMB : (k == 3) ? K_GEMMB : (k == 4) ? K_ATTN : (k == 5) ? K_GWO : (k == 6) ? K_NORM2 : (k == 7) ? K_GUP : K_GDOWN; return; }
    kind = K_FINAL; l = 3;
}


#define XB_TMO      128
#define XB_XCNT(j)  (256  + 64 * (j))
#define XB_XSUB(j)  (1280 + 64 * (j))
#define XB_XGEN(j)  (2304 + 64 * (j))
#define XB_TOP      3328
#define XB_TOPGEN   3392
#define XCD_BAR_WORDS 3456
#define XB_SPIN_CAP (1u << 22)
constexpr size_t WS_BAR = 10 * MiB;
__device__ __forceinline__ unsigned xb_ld(unsigned* p)              { return __hip_atomic_load(p, __ATOMIC_RELAXED, __HIP_MEMORY_SCOPE_AGENT); }
__device__ __forceinline__ unsigned xb_add(unsigned* p, unsigned v) { return __hip_atomic_fetch_add(p, v, __ATOMIC_RELAXED, __HIP_MEMORY_SCOPE_AGENT); }
__device__ __forceinline__ unsigned xb_xcc_id() { return (unsigned)__builtin_amdgcn_s_getreg((3 << 11) | 20) & 0xFu; }
#define XB_SPIN(cond, bar) do { unsigned _sp = 0; while (cond) { __builtin_amdgcn_s_sleep(1); \
    if ((++_sp & 255u) == 0u) { if (xb_ld(&(bar)[XB_TMO])) break; if (_sp > XB_SPIN_CAP) { atomicAdd(&(bar)[XB_TMO], 1u); break; } } } } while (0)
__device__ __forceinline__ void xcd_barrier_complete(unsigned* bar, unsigned x, unsigned& nloc, unsigned& nx) {
    const unsigned G = gridDim.x;
    unsigned sum, cnt, mine, sp = 0u;
    for (;;) {
        sum = 0u; cnt = 0u; mine = 0u;
#pragma unroll
        for (unsigned j = 0; j < 16; ++j) { const unsigned c = xb_ld(&bar[XB_XCNT(j)]); sum += c; cnt += (c > 0u) ? 1u : 0u; mine = (j == x) ? c : mine; }
        if (sum == G) break;
        __builtin_amdgcn_s_sleep(1);
        if ((++sp & 255u) == 0u) { if (xb_ld(&bar[XB_TMO])) break; if (sp > XB_SPIN_CAP) { atomicAdd(&bar[XB_TMO], 1u); break; } }
    }
    nloc = mine > 0u ? mine : 1u; nx = cnt > 0u ? cnt : 1u;
}
__device__ __forceinline__ void xcd_barrier(unsigned* bar, unsigned x, volatile LAS unsigned* st, bool leader_thread) {
    asm volatile("s_waitcnt vmcnt(0)" ::: "memory");
    __syncthreads();
    if (leader_thread) {
        __builtin_amdgcn_s_waitcnt(0);
        unsigned nloc = st[0], nx = st[1];
        if (nloc == 0u) { xcd_barrier_complete(bar, x, nloc, nx); st[0] = nloc; st[1] = nx; }
        const unsigned old = xb_add(&bar[XB_XSUB(x)], 1u);
        const unsigned gen = old / nloc;
        if (old + 1u == (gen + 1u) * nloc) {
            __builtin_amdgcn_fence(__ATOMIC_RELEASE, "agent");
            asm volatile("s_waitcnt vmcnt(0)" ::: "memory");
            const unsigned og = xb_add(&bar[XB_TOP], 1u);
            const unsigned tg = og / nx;
            if (og + 1u == (tg + 1u) * nx) xb_add(&bar[XB_TOPGEN], 1u);
            else XB_SPIN(xb_ld(&bar[XB_TOPGEN]) == tg, bar);
            __builtin_amdgcn_fence(__ATOMIC_ACQUIRE, "agent");
            xb_add(&bar[XB_XGEN(x)], 1u);
            asm volatile("s_waitcnt vmcnt(0)" ::: "memory");
        } else {
            XB_SPIN(xb_ld(&bar[XB_XGEN(x)]) == gen, bar);
            __builtin_amdgcn_fence(__ATOMIC_ACQUIRE, "agent");
            asm volatile("s_waitcnt vmcnt(0)" ::: "memory");
        }
    }
    __syncthreads();
}

__global__ void __launch_bounds__(NTHR, 2) fwd_megakernel(Args a_unused) {
    extern __shared__ __attribute__((aligned(16))) unsigned char lds_raw[];
    cg::grid_group grid = cg::this_grid();
    LAS unsigned char* lds = (LAS unsigned char*)lds_raw;
    LAS unsigned char* xl = lds + XCH_OFF;
    const int G = gridDim.x, NGW = G * NWAVES;
    volatile LAS unsigned* bst = (volatile LAS unsigned*)(lds + LDS_BYTES - 16);
    if (threadIdx.x == 0) { bst[0] = 0u; bst[1] = 0u; (void)xb_add((unsigned*)(a_unused.ws + WS_BAR) + XB_XCNT(xb_xcc_id()), 1u); }
    __syncthreads();
    grid.sync();
    const int wave0 = __builtin_amdgcn_readfirstlane(threadIdx.x >> 6);
    for (int ph = 0; ph < NPHASE; ++ph) {
        ArgsP a = (ArgsP)__builtin_amdgcn_kernarg_segment_ptr(); asm volatile("" : "+s"(a));
        int wv = wave0; asm volatile("" : "+s"(wv));
#define TIDNOW() ([&]() { int t_; asm volatile("v_mbcnt_lo_u32_b32 %0, -1, 0\n\tv_mbcnt_hi_u32_b32 %0, -1, %0" : "=v"(t_)); return t_ + wv * 64; })()
        const int tid = TIDNOW();
        int bid = blockIdx.x; asm volatile("" : "+s"(bid));
        unsigned char* ws = a->ws; asm volatile("" : "+s"(ws)); ASSUME_GLOBAL(ws);
        float* outp = a->out; asm volatile("" : "+s"(outp)); ASSUME_GLOBAL(outp);
        const int lane = tid & 63, wave = __builtin_amdgcn_readfirstlane(tid >> 6), gw = bid * NWAVES + wave;
        float* mods = (float*)(ws + WS_MODS); const float* cs = (const float*)(ws + WS_CS);
        bf16_t* XB = (bf16_t*)(ws + WS_XB); bf16_t* Hb = (bf16_t*)(ws + WS_H); bf16_t* KVb = (bf16_t*)(ws + WS_KV); bf16_t* KRb = (bf16_t*)(ws + WS_KR); unsigned char* ACT = ws + WS_ACT;
        int kind, l; phase_of(ph, kind, l);
        const float* mods_l = mods + (size_t)l * 8 * 6144;
        const int j = l - 2;
        switch (kind) {
        case K_PREP: { const int tid_ = TIDNOW(); prep_phase(a, lds, tid_, tid_ & 63, wave, bid); } break;
        case K_NORM1: if (l == 0) norm_rows(AF(x), AF(norm1_g) + l * DM, mods_l, 0, 1, Hb, nullptr, nullptr, gw, NGW, lane);
                      else norm_rows_b(XB, AF(norm1_g) + l * DM, mods_l, 0, 1, Hb, nullptr, nullptr, gw, NGW, lane);
                      break;
        case K_NORM2: norm_rows_b(XB, AF(norm2_g) + l * DM, mods_l, 3, 4, Hb, nullptr, nullptr, gw, NGW, lane); ffn_weights(a, lds, l, lane, wave, bid); break;
        case K_POOLED: pooled_phase(Hb, (bf16_t*)ACT, bid * NTHR + TIDNOW(), G * NTHR); break;
        case K_NORMA: norm_rows_b(XB, AF(norm1_g) + l * DM, mods_l, 0, 1, (bf16_t*)(ACT + ACT_Q), AF(kv_in_g), (l == 2) ? Hb : nullptr, gw, NGW, lane); break;
        case K_NORMB:
            cq_norm((const bf16_t*)(ACT + ACT_CQRAW), AF(q_norm_g) + j * 384, Hb, gw, NGW, lane);
            if (l == 2) ckv_norm((const bf16_t*)(ACT + ACT_KVRAW), AF(ckv_norm_g), cs, (bf16_t*)(ACT + ACT_CKV), KRb, gw, NGW, lane);
            break;
        case K_GPOOL: case K_GDOWN: case K_GWO: {
            pg8::Gemm g; pg8::EpiRes E; E.out = XB; E.base = XB; E.base_f32 = 0; E.pb = nullptr; E.ps = nullptr;
            if (kind == K_GPOOL) { g = pg8::Gemm{(const bf16_t*)ACT, (const bf16_t*)(ws + WS_WPOOL) + (size_t)l * 4 * 65536, 1024, 256, 256}; if (l == 0) { E.base = AF(x); E.base_f32 = 1; } E.gate = mods_l + 2 * 1024; E.pb = AF(pool_b) + l * DM; E.ps = AF(pool_scale) + l * DM; }
            else if (kind == K_GDOWN) { g = pg8::Gemm{(const bf16_t*)ACT, (const bf16_t*)(ws + WS_WDN), FF, FF, 0}; E.gate = mods_l + 5 * 1024; }
            else { g = pg8::Gemm{(const bf16_t*)(ACT + ACT_O), (const bf16_t*)(ws + WS_WO) + (size_t)j * 1024 * 1024, 1024, 1024, 0}; E.gate = mods_l + 2 * 1024; }
            pg8::Order S; S.init(128, 4, G, bid);
            if (kind == K_GDOWN) {
                const float* cw = AF(conv_w) + (size_t)l * 3 * FF; const float* cb = AF(conv_b) + (size_t)l * FF;
                const float* topa = (const float*)(ws + WS_TOPA); const float* topv = (const float*)(ws + WS_TOPV); const float* bota = (const float*)(ws + WS_BOTA); bf16_t* act = (bf16_t*)ACT;
                for (int i = 0; ; ++i) { pg8::Unit u; if (!S.next(i, u)) break; if ((u.pm & 15) == 0) continue;
                    for (int e = TIDNOW(); e < 2 * FF; e += NTHR) { const int i2 = e >= FF ? 1 : 0, f = e - i2 * FF;
                        const float b0 = bota[(size_t)((u.pm - 1) * 2) * FF + f], b1 = bota[(size_t)((u.pm - 1) * 2 + 1) * FF + f], t0v = topa[(size_t)(u.pm * 2) * FF + f], t1v = topa[(size_t)(u.pm * 2 + 1) * FF + f];
                        const float am2 = i2 ? b1 : b0, am1 = i2 ? t0v : b1, cur = i2 ? t1v : t0v, v = topv[(size_t)(u.pm * 2 + i2) * FF + f];
                        const float ac = cw[f] * am2 + cw[FF + f] * am1 + cw[2 * FF + f] * cur + cb[f];
                        const f32x2 gg = pg8::gelu_pk((f32x2){ac, ac});
                        act[(size_t)(u.pm * 256 + i2) * FF + f] = (bf16_t)f2bf(gg.x * v); } }
                asm volatile("s_waitcnt vmcnt(0)" ::: "memory"); __syncthreads();
            }
            pg8::gemm_phase<pg8::EpiRes, 0>(lds, xl, g, S, E, TIDNOW());
        } break;
        case K_GUP: {
            pg8::Gemm g{Hb, (const bf16_t*)(ws + WS_WUP), 1024, 1024, 0};
            pg8::EpiUp E{(bf16_t*)ACT, AF(conv_w) + (size_t)l * 3 * FF, AF(conv_b) + (size_t)l * FF, (float*)(ws + WS_TOPA), (float*)(ws + WS_TOPV), (float*)(ws + WS_BOTA)};
            pg8::Order S; S.init(128, 22, G, bid);
            pg8::gemm_phase<pg8::EpiUp, 0>(lds, xl, g, S, E, TIDNOW());
        } break;
        case K_GEMMA: case K_GEMMB: {
            if (kind == K_GEMMB) {
                pg8::Gemm g{Hb, (const bf16_t*)(ws + WS_WUQ + j * WUQ_SZ), 384, 384, 0};
                pg8::EpiQ E{(bf16_t*)(ACT + ACT_Q), cs};
                pg8::Order S; S.init(128, 6, G, bid);
                pg8::gemm_phase<pg8::EpiQ, 0>(lds, xl, g, S, E, TIDNOW());
            }
            const int ng = (kind == K_GEMMA) ? (l == 2 ? 2 : 1) : (l == 2 ? 1 : 0);
            for (int i = 0; i < ng; ++i) {
                pg8::Gemm g; pg8::EpiBf16 E; int nN;
                if (kind == K_GEMMA && i == 0) { g = pg8::Gemm{(const bf16_t*)(ACT + ACT_Q), (const bf16_t*)(ws + WS_WDQ) + (size_t)j * 512 * 1024, 1024, 1024, 0}; E = pg8::EpiBf16{(bf16_t*)(ACT + ACT_CQRAW), 512}; nN = 2; }
                else if (kind == K_GEMMA) { g = pg8::Gemm{Hb, (const bf16_t*)(ws + WS_WDKV), 1024, 1024, 0}; E = pg8::EpiBf16{(bf16_t*)(ACT + ACT_KVRAW), 512}; nN = 2; }
                else { g = pg8::Gemm{(const bf16_t*)(ACT + ACT_CKV), (const bf16_t*)(ws + WS_WKV), 256, 256, 0}; E = pg8::EpiBf16{KVb, 2048}; nN = 8; }
                pg8::Order S; S.init(128, nN, G, bid);
                pg8::gemm_phase<pg8::EpiBf16, 0>(lds, xl, g, S, E, TIDNOW());
            }
        } break;
        case K_ATTN: att::attn_phase((char*)lds_raw, (const bf16_t*)(ACT + ACT_Q), KVb, KRb, (bf16_t*)(ACT + ACT_O), TIDNOW(), bid); break;
        case K_FINAL: final_norm(XB, outp, AF(final_g), gw, NGW, lane);
            break;
        }
        if (ph + 1 < NPHASE) xcd_barrier((unsigned*)(ws + WS_BAR), xb_xcc_id(), bst, TIDNOW() == 0);
    }
}

extern "C" void kernel_launch(void* const* d_in, const int* in_sizes, int n_in, void* d_out, int out_size, void* d_ws, size_t ws_size, hipStream_t stream) {
    static int grid = 0;
    if (grid == 0) {
        if (n_in != 24 || out_size != MT * DM || ws_size < WS_END) { fprintf(stderr, "kernel_launch: unexpected shapes (n_in %d out %d ws %zu need %zu)\n", n_in, out_size, ws_size, (size_t)WS_END); grid = -1; return; }
        int dev = 0, cus = 0, per_cu = 0;
        (void)hipGetDevice(&dev);
        if (hipDeviceGetAttribute(&cus, hipDeviceAttributeMultiprocessorCount, dev) != hipSuccess || cus <= 0) cus = 256;
        if (hipFuncSetAttribute((const void*)fwd_megakernel, hipFuncAttributeMaxDynamicSharedMemorySize, LDS_BYTES) != hipSuccess) { fprintf(stderr, "kernel_launch: hipFuncSetAttribute failed\n"); grid = -1; return; }
        if (hipOccupancyMaxActiveBlocksPerMultiprocessor(&per_cu, (const void*)fwd_megakernel, NTHR, LDS_BYTES) != hipSuccess || per_cu < 1) { fprintf(stderr, "kernel_launch: occupancy query gave %d\n", per_cu); per_cu = 1; }
        (void)hipGetLastError();
        grid = cus * per_cu;
    }
    if (grid < 0) return;
    Args a{};
    a.x = (const float*)d_in[0]; a.c = (const float*)d_in[1]; a.pos = (const int*)d_in[2]; a.mod_w = (const float*)d_in[3]; a.mod_b = (const float*)d_in[4];
    a.norm1_g = (const float*)d_in[5]; a.norm2_g = (const float*)d_in[6]; a.pool_w = (const float*)d_in[7]; a.pool_b = (const float*)d_in[8]; a.pool_scale = (const float*)d_in[9];
    a.kv_in_g = (const float*)d_in[10]; a.w_dkv = (const float*)d_in[11]; a.ckv_norm_g = (const float*)d_in[12]; a.w_uk = (const float*)d_in[13]; a.w_uv = (const float*)d_in[14];
    a.w_dq = (const float*)d_in[15]; a.q_norm_g = (const float*)d_in[16]; a.w_uq = (const float*)d_in[17]; a.w_o = (const float*)d_in[18];
    a.w_up = (const float*)d_in[19]; a.conv_w = (const float*)d_in[20]; a.conv_b = (const float*)d_in[21]; a.w_down = (const float*)d_in[22]; a.final_g = (const float*)d_in[23];
    a.out = (float*)d_out; a.ws = (unsigned char*)d_ws;
    if (hipMemsetAsync((char*)d_ws + WS_BAR, 0, 16384, stream) != hipSuccess) { fprintf(stderr, "kernel_launch: hipMemsetAsync failed\n"); return; }
    void* args[] = {&a};
    hipError_t e = hipLaunchCooperativeKernel((const void*)fwd_megakernel, dim3(grid), dim3(NTHR), args, LDS_BYTES, stream);
    if (e != hipSuccess) fprintf(stderr, "kernel_launch: cooperative launch failed: %s (grid %d)\n", hipGetErrorString(e), grid);
}
```

```cpp
#include <hip/hip_runtime.h>
#include <hip/hip_cooperative_groups.h>
#include <cstdio>
#include <cstdint>
namespace cg = cooperative_groups;

#define LAS __attribute__((address_space(3)))
typedef unsigned short bf16_t;
typedef short bf16x8 __attribute__((ext_vector_type(8)));
typedef short s16x4 __attribute__((ext_vector_type(4)));
typedef float f32x2 __attribute__((ext_vector_type(2)));
typedef float f32x4 __attribute__((ext_vector_type(4)));
typedef float f32x16 __attribute__((ext_vector_type(16)));
typedef unsigned u32x2 __attribute__((ext_vector_type(2)));
typedef unsigned u32x4 __attribute__((ext_vector_type(4)));

constexpr int NB = 8, SEQ = 4096, DM = 1024, MT = NB * SEQ, FF = 2816, NH = 8;
constexpr int NWAVES = 8, NTHR = 512;
constexpr float EPS = 1e-6f;
constexpr size_t MiB = 1u << 20;
constexpr size_t WS_MODS = 0;
constexpr size_t WS_CS = 1 * MiB;
constexpr size_t WS_WUP = 16 * MiB;
constexpr size_t WUP_SZ = (size_t)5632 * 1024 * 2;
constexpr size_t WS_WDN = WS_WUP + WUP_SZ;
constexpr size_t WDN_SZ = (size_t)1024 * 2816 * 2;
constexpr size_t WS_WPOOL = WS_WDN + WDN_SZ;
constexpr size_t WS_WDKV = WS_WPOOL + 1 * MiB;
constexpr size_t WS_WKV = WS_WDKV + 1 * MiB;
constexpr size_t WS_WDQ = WS_WKV + 1 * MiB;
constexpr size_t WS_WUQ = WS_WDQ + 2 * MiB;
constexpr size_t WUQ_SZ = (size_t)1536 * 384 * 2;
constexpr size_t WS_WO = WS_WUQ + 2 * WUQ_SZ + 0;
constexpr size_t WS_WEND = WS_WO + 4 * MiB;
static_assert(WS_WEND <= 45 * MiB, "weights region");
constexpr size_t WS_TOPA = 45 * MiB, WS_TOPV = 48 * MiB, WS_BOTA = 51 * MiB;
constexpr size_t WS_H = 54 * MiB + 4096;
constexpr size_t WS_XB = 119 * MiB;
constexpr size_t WS_KV = 183 * MiB;
constexpr size_t WS_KR = 311 * MiB;
constexpr size_t WS_ACT = 315 * MiB;
constexpr size_t WS_END = 491 * MiB;
constexpr size_t ACT_Q = 0, ACT_O = 96 * MiB, ACT_CQRAW = 96 * MiB, ACT_KVRAW = 128 * MiB, ACT_CKV = 160 * MiB;

constexpr int RING_BYTES = 131072, XCH_OFF = RING_BYTES, LDS_BYTES = 155648;

struct Args {
    const float* x; const float* c; const int* pos; const float* mod_w; const float* mod_b; const float* norm1_g; const float* norm2_g;
    const float* pool_w; const float* pool_b; const float* pool_scale; const float* kv_in_g; const float* w_dkv; const float* ckv_norm_g;
    const float* w_uk; const float* w_uv; const float* w_dq; const float* q_norm_g; const float* w_uq; const float* w_o;
    const float* w_up; const float* conv_w; const float* conv_b; const float* w_down; const float* final_g;
    float* out; unsigned char* ws;
};

typedef const __attribute__((address_space(4))) Args* ArgsP;
#define GAS __attribute__((address_space(1)))
#if defined(__HIP_DEVICE_COMPILE__)
#define ASSUME_GLOBAL(p) __builtin_assume(!__builtin_amdgcn_is_shared((const __attribute__((address_space(0))) void*)(p)) && !__builtin_amdgcn_is_private((const __attribute__((address_space(0))) void*)(p)))
#else
#define ASSUME_GLOBAL(p) ((void)0)
#endif
#define AF(name) ([&]() { const float* p_ = a->name; ASSUME_GLOBAL(p_); return p_; })()
#define AI(name) ([&]() { const int* p_ = a->name; ASSUME_GLOBAL(p_); return p_; })()

__device__ __forceinline__ unsigned f2bf(float f) { unsigned u = __builtin_bit_cast(unsigned, f); return (u + 0x7fffu + ((u >> 16) & 1u)) >> 16; }
__device__ __forceinline__ unsigned pk2(float lo, float hi) { return f2bf(lo) | (f2bf(hi) << 16); }
__device__ __forceinline__ unsigned cvt_pk_bf16(float lo, float hi) { unsigned r; asm volatile("v_cvt_pk_bf16_f32 %0, %1, %2" : "=v"(r) : "v"(lo), "v"(hi)); return r; }
__device__ __forceinline__ float bflo(unsigned u) { return __builtin_bit_cast(float, u << 16); }
__device__ __forceinline__ float bfhi(unsigned u) { return __builtin_bit_cast(float, u & 0xffff0000u); }
__device__ __forceinline__ void swap16_self(unsigned x, unsigned& r0, unsigned& r1) { unsigned y = x; asm("" : "+v"(y)); auto r = __builtin_amdgcn_permlane16_swap(x, y, false, false); r0 = r[0]; r1 = r[1]; }
__device__ __forceinline__ void swap32_self(unsigned x, unsigned& r0, unsigned& r1) { unsigned y = x; asm("" : "+v"(y)); auto r = __builtin_amdgcn_permlane32_swap(x, y, false, false); r0 = r[0]; r1 = r[1]; }
#define DPPF(v, ctrl) __builtin_bit_cast(float, __builtin_amdgcn_update_dpp(0, __builtin_bit_cast(int, (v)), (ctrl), 0xf, 0xf, false))
__device__ __forceinline__ float wave_sum(float v) {
    v += DPPF(v, 0xB1); v += DPPF(v, 0x4E); v += DPPF(v, 0x141); v += DPPF(v, 0x140);
    unsigned a, b;
    swap16_self(__builtin_bit_cast(unsigned, v), a, b); v = __builtin_bit_cast(float, a) + __builtin_bit_cast(float, b);
    swap32_self(__builtin_bit_cast(unsigned, v), a, b); v = __builtin_bit_cast(float, a) + __builtin_bit_cast(float, b);
    return v;
}
#define LDS_WAIT() asm volatile("s_waitcnt lgkmcnt(0)" ::: "memory")

namespace pg8 {
constexpr int BM = 256, BK = 64, HALF = 128, HTB = HALF * BK * 2, NXCD = 8, WGM = 8;
__device__ __forceinline__ int lds_byte(int r, int c) { const int st = (r >> 4) * 2 + (c >> 5), rr = r & 15, cc = c & 31, ob = rr * 64 + cc * 2; return st * 1024 + (ob ^ (((ob >> 9) & 1) << 5)); }
__device__ __forceinline__ void stage_rc(int b, int& R, int& C) { const int st = b / 1024, sb = b % 1024, swz = sb ^ (((sb >> 9) & 1) << 5); R = (st >> 1) * 16 + swz / 64; C = (st & 1) * 32 + (swz % 64) / 2; }
__device__ __forceinline__ int perm32(int rho) { const int n = rho >> 4, i = rho & 15; return 8 * (i >> 2) + 4 * n + (i & 3); }
struct Unit { int pm, pn; };
struct Order {
    int nM, nN, nwg, G, c;
    __device__ void init(int nM_, int nN_, int G_, int c_) { nM = nM_; nN = nN_; nwg = nM * nN; G = G_; c = c_; }
    __device__ bool next(int i, Unit& u) const {
        const long L = (long)i * G + c; if (L >= nwg) return false;
        int wgid = (int)L; { const int q = nwg / NXCD, r = nwg % NXCD, xcd = wgid % NXCD, off = wgid / NXCD; wgid = (xcd < r ? xcd * (q + 1) : r * (q + 1) + (xcd - r) * q) + off; }
        const int nig = WGM * nN, gid = wgid / nig, fm = gid * WGM, gsz = (nM - fm) < WGM ? (nM - fm) : WGM;
        u.pm = fm + ((wgid % nig) % gsz); u.pn = (wgid % nig) / gsz; return true;
    }
};
struct Gemm { const bf16_t* A; const bf16_t* Bt; int lda; int K; int acs; };
template <int MODE> __device__ __forceinline__ ptrdiff_t a_off(const Gemm& g, const Unit& u) {
    if (MODE == 2) { const int b = u.pm / 17, j = u.pm - b * 17; return ((ptrdiff_t)(b * 4096 + j * 254 - 2) * g.lda) * 2; }
    return ((ptrdiff_t)u.pm * 256 * g.lda + (ptrdiff_t)u.pn * g.acs) * 2;
}

__device__ __forceinline__ f32x2 gelu_pk(f32x2 v) {
    const f32x2 z = __builtin_elementwise_min(__builtin_elementwise_max(v, (f32x2){-4.3f, -4.3f}), (f32x2){4.3f, 4.3f}) * 0.232558139534883721f, u = z * z;
    f32x2 q = u * 2.9056504693371608f + (-15.464755185649892f);
    q = q * u + 36.337021862829715f; q = q * u + (-50.1697976120365f); q = q * u + 45.89880639920095f; q = q * u + (-29.836445535451812f);
    q = q * u + 14.38621083521653f; q = q * u + (-5.271915130776272f); q = q * u + 1.7152232528538645f;
    return v * (z * q + 0.5f);
}

struct EpiRes {
    static constexpr bool PERM = true;
    const void* base; int base_f32; bf16_t* out; const float* gate; const float* pb; const float* ps;
    __device__ __forceinline__ void operator()(const f32x4 (&acc)[2][2][4][2], const Unit& u, int wr, int wc, int fr, int fq, LAS unsigned char*, int) const {
        const int b = u.pm >> 4, row0 = u.pm * BM + wr * 64 + fr, col0 = u.pn * BM + wc * 32 + 8 * fq;
        f32x4 mul[2][2], add[2][2];
#pragma unroll
        for (int bj = 0; bj < 2; ++bj)
#pragma unroll
            for (int n = 0; n < 2; ++n) { const int col = col0 + bj * HALF + n * 4; const f32x4 g = *(const GAS f32x4*)(gate + b * 6144 + col);
                if (pb) { const f32x4 s = *(const GAS f32x4*)(ps + col), bb = *(const GAS f32x4*)(pb + col); mul[bj][n] = g * s; add[bj][n] = mul[bj][n] * bb; }
                else { mul[bj][n] = g; add[bj][n] = (f32x4){0.f, 0.f, 0.f, 0.f}; } }
#pragma unroll
        for (int ai = 0; ai < 2; ++ai)
#pragma unroll
            for (int m = 0; m < 4; ++m) { const size_t off = (size_t)(row0 + ai * HALF + m * 16) * DM + col0;
#pragma unroll
                for (int bj = 0; bj < 2; ++bj) { f32x4 b0, b1;
                    if (base_f32) { b0 = *(const GAS f32x4*)((const float*)base + off + bj * HALF); b1 = *(const GAS f32x4*)((const float*)base + off + bj * HALF + 4); }
                    else { const u32x4 w = *(const GAS u32x4*)((const bf16_t*)base + off + bj * HALF); b0 = (f32x4){bflo(w.x), bfhi(w.x), bflo(w.y), bfhi(w.y)}; b1 = (f32x4){bflo(w.z), bfhi(w.z), bflo(w.w), bfhi(w.w)}; }
                    const f32x4 v0 = b0 + acc[ai][bj][m][0] * mul[bj][0] + add[bj][0], v1 = b1 + acc[ai][bj][m][1] * mul[bj][1] + add[bj][1];
                    u32x4 o; o.x = cvt_pk_bf16(v0[0], v0[1]); o.y = cvt_pk_bf16(v0[2], v0[3]); o.z = cvt_pk_bf16(v1[0], v1[1]); o.w = cvt_pk_bf16(v1[2], v1[3]);
                    *(GAS u32x4*)(out + off + bj * HALF) = o; } }
    }
};
struct EpiBf16 {
    static constexpr bool PERM = true;
    bf16_t* O; int ldc;
    __device__ __forceinline__ void operator()(const f32x4 (&acc)[2][2][4][2], const Unit& u, int wr, int wc, int fr, int fq, LAS unsigned char*, int) const {
        const int row0 = u.pm * BM + wr * 64 + fr, col0 = u.pn * BM + wc * 32 + 8 * fq;
#pragma unroll
        for (int ai = 0; ai < 2; ++ai)
#pragma unroll
            for (int m = 0; m < 4; ++m) { bf16_t* rowp = O + (size_t)(row0 + ai * HALF + m * 16) * ldc + col0;
#pragma unroll
                for (int bj = 0; bj < 2; ++bj) { const f32x4 v0 = acc[ai][bj][m][0], v1 = acc[ai][bj][m][1];
                    u32x4 w; w.x = cvt_pk_bf16(v0[0], v0[1]); w.y = cvt_pk_bf16(v0[2], v0[3]); w.z = cvt_pk_bf16(v1[0], v1[1]); w.w = cvt_pk_bf16(v1[2], v1[3]);
                    *(GAS u32x4*)(rowp + bj * HALF) = w; } }
    }
};
struct EpiQ {
    static constexpr bool PERM = true;
    bf16_t* O; const float* cs;
    __device__ __forceinline__ void operator()(const f32x4 (&acc)[2][2][4][2], const Unit& u, int wr, int wc, int fr, int fq, LAS unsigned char*, int) const {
        const int row0 = u.pm * BM + wr * 64 + fr;
#pragma unroll
        for (int bj = 0; bj < 2; ++bj) { const int c0 = u.pn * BM + bj * HALF + wc * 32 + 8 * fq, hc = c0 % 192; const bool rope = hc >= 128; const int i0 = (hc - 128) >> 1;
#pragma unroll
            for (int ai = 0; ai < 2; ++ai)
#pragma unroll
                for (int m = 0; m < 4; ++m) { const int row = row0 + ai * HALF + m * 16; f32x4 v0 = acc[ai][bj][m][0], v1 = acc[ai][bj][m][1];
                    if (rope) { const f32x4 ca = *(const GAS f32x4*)(cs + (size_t)row * 64 + i0 * 2), cb = *(const GAS f32x4*)(cs + (size_t)row * 64 + i0 * 2 + 4);
                        f32x4 r0, r1;
                        r0[0] = v0[0] * ca[0] - v0[1] * ca[1]; r0[1] = v0[1] * ca[0] + v0[0] * ca[1]; r0[2] = v0[2] * ca[2] - v0[3] * ca[3]; r0[3] = v0[3] * ca[2] + v0[2] * ca[3];
                        r1[0] = v1[0] * cb[0] - v1[1] * cb[1]; r1[1] = v1[1] * cb[0] + v1[0] * cb[1]; r1[2] = v1[2] * cb[2] - v1[3] * cb[3]; r1[3] = v1[3] * cb[2] + v1[2] * cb[3];
                        v0 = r0; v1 = r1; }
                    u32x4 w; w.x = cvt_pk_bf16(v0[0], v0[1]); w.y = cvt_pk_bf16(v0[2], v0[3]); w.z = cvt_pk_bf16(v1[0], v1[1]); w.w = cvt_pk_bf16(v1[2], v1[3]);
                    *(GAS u32x4*)(O + (size_t)row * 1536 + c0) = w; } }
    }
};
__device__ __forceinline__ float dpp_prev1(float cur, float prev) {
    const int o = __builtin_amdgcn_mov_dpp(__builtin_bit_cast(int, prev), 0x121, 0xf, 0xf, true);
    return __builtin_bit_cast(float, __builtin_amdgcn_update_dpp(o, __builtin_bit_cast(int, cur), 0x111, 0xf, 0xf, false));
}
__device__ __forceinline__ float dpp_prev2(float cur, float prev) {
    const int o = __builtin_amdgcn_mov_dpp(__builtin_bit_cast(int, prev), 0x122, 0xf, 0xf, true);
    return __builtin_bit_cast(float, __builtin_amdgcn_update_dpp(o, __builtin_bit_cast(int, cur), 0x112, 0xf, 0xf, false));
}
struct EpiUp {
    static constexpr bool PERM = true;
    bf16_t* act; const float* cw; const float* cb; float* topa; float* topv; float* bota;
    __device__ __forceinline__ void operator()(const f32x4 (&acc)[2][2][4][2], const Unit& u, int wr, int wc, int fr, int fq, LAS unsigned char* xl, int) const {
        const int jt = u.pm & 15, t0 = jt * 256;
        const int f0 = u.pn * 128 + wc * 32 + 8 * fq;
        if (fr >= 14) {
#pragma unroll
            for (int ai = 0; ai < 2; ++ai) { LAS f32x4* p = (LAS f32x4*)(xl + ((ai * 2 + wr) * 4 + wc) * 256 + ((fr & 1) * 4 + fq) * 32); p[0] = acc[ai][0][3][0]; p[1] = acc[ai][0][3][1]; }
        }
        LDS_WAIT(); __builtin_amdgcn_s_barrier(); asm volatile("" ::: "memory");
        f32x4 halo[2][2];
#pragma unroll
        for (int ai = 0; ai < 2; ++ai) {
            const int sa = wr ? ai : 0, sw = wr ? 0 : 1;
            const LAS f32x4* p = (const LAS f32x4*)(xl + ((sa * 2 + sw) * 4 + wc) * 256 + ((fr & 1) * 4 + fq) * 32);
            halo[ai][0] = p[0]; halo[ai][1] = p[1];
        }
        f32x4 w0[2], w1[2], w2[2], bb[2];
#pragma unroll
        for (int n = 0; n < 2; ++n) { w0[n] = *(const GAS f32x4*)(cw + f0 + 4 * n); w1[n] = *(const GAS f32x4*)(cw + FF + f0 + 4 * n); w2[n] = *(const GAS f32x4*)(cw + 2 * FF + f0 + 4 * n); bb[n] = *(const GAS f32x4*)(cb + f0 + 4 * n); }
        LDS_WAIT();
#pragma unroll
        for (int ai = 0; ai < 2; ++ai)
#pragma unroll
            for (int m = 0; m < 4; ++m) {
                const int r = ai * HALF + wr * 64 + m * 16 + fr, t = t0 + r;
                f32x4 o[2];
#pragma unroll
                for (int n = 0; n < 2; ++n) {
                    const f32x4 c = acc[ai][0][m][n]; const f32x4 p = (m > 0) ? acc[ai][0][m > 0 ? m - 1 : 0][n] : halo[ai][n];
                    f32x4 x1, x2;
#pragma unroll
                    for (int j = 0; j < 4; ++j) { x1[j] = dpp_prev1(c[j], p[j]); x2[j] = dpp_prev2(c[j], p[j]); }
                    if (ai == 0 && m == 0) { if (t0 == 0 && wr == 0) {
                        if (t < 1) x1 = (f32x4){0.f, 0.f, 0.f, 0.f};
                        if (t < 2) x2 = (f32x4){0.f, 0.f, 0.f, 0.f}; } }
                    const f32x4 a = __builtin_elementwise_fma(x2, w0[n], __builtin_elementwise_fma(x1, w1[n], __builtin_elementwise_fma(c, w2[n], bb[n])));
                    const f32x2 g0 = gelu_pk((f32x2){a[0], a[1]}), g1 = gelu_pk((f32x2){a[2], a[3]});
                    const f32x4 v = acc[ai][1][m][n];
                    const f32x2 r0 = g0 * (f32x2){v[0], v[1]}, r1 = g1 * (f32x2){v[2], v[3]};
                    o[n] = (f32x4){r0.x, r0.y, r1.x, r1.y};
                }
                u32x4 w; w.x = cvt_pk_bf16(o[0][0], o[0][1]); w.y = cvt_pk_bf16(o[0][2], o[0][3]); w.z = cvt_pk_bf16(o[1][0], o[1][1]); w.w = cvt_pk_bf16(o[1][2], o[1][3]);
                const bool deferred = (ai == 0 && m == 0) && (wr == 0 && jt > 0 && fr < 2);
                if (!deferred) *(GAS u32x4*)(act + (size_t)(u.pm * BM + r) * FF + f0) = w;
                if (ai == 0 && m == 0) { if (wr == 0 && jt > 0 && fr < 2) { float* pa = topa + (size_t)(u.pm * 2 + fr) * FF + f0; float* pv = topv + (size_t)(u.pm * 2 + fr) * FF + f0;
                        *(GAS f32x4*)pa = acc[0][0][0][0]; *(GAS f32x4*)(pa + 4) = acc[0][0][0][1]; *(GAS f32x4*)pv = acc[0][1][0][0]; *(GAS f32x4*)(pv + 4) = acc[0][1][0][1]; } }
                if (ai == 1 && m == 3) { if (wr == 1 && fr >= 14) { float* pb = bota + (size_t)(u.pm * 2 + (fr - 14)) * FF + f0; *(GAS f32x4*)pb = acc[1][0][3][0]; *(GAS f32x4*)(pb + 4) = acc[1][0][3][1]; } }
            }
    }
};

template <class Epi, int MODE>
__device__ __forceinline__ void gemm_phase(LAS unsigned char* lds, LAS unsigned char* xl, const Gemm g, const Order& S, const Epi& E, const int tid) {
    const int wid = __builtin_amdgcn_readfirstlane(tid >> 6), lane = tid & 63, wr = wid >> 2, wc = wid & 3, fr = lane & 15, fq = lane >> 4;
    const int K = g.K, nt = K / BK, lda = g.lda;
    unsigned voffA[2], voffB[2];
#pragma unroll
    for (int i = 0; i < 2; ++i) { int R, C; stage_rc(tid * 16 + i * 8192, R, C); const int Rb = Epi::PERM ? ((R & ~31) + perm32(R & 31)) : R;
        voffA[i] = (unsigned)(R * lda + C) * 2u; voffB[i] = (unsigned)(Rb * K + C) * 2u; }
    const size_t kstep = (size_t)(BK * 2);
    const size_t hstepA = (size_t)HALF * lda * 2, hstepB = (size_t)HALF * K * 2;
    const size_t tstepB = 2 * hstepB;
    const unsigned ldsw = (unsigned)wid * 1024u, ldsbase = (unsigned)(uintptr_t)lds;
    const int aoff = lds_byte(wr * 64 + fr, fq * 8), boff = lds_byte(wc * 32 + fr, fq * 8);
#define PG8_SA(b, h) (((b) * 2 + (h)) * HTB)
#define PG8_SB(b, h) ((4 + (b) * 2 + (h)) * HTB)
#define PG8_STAGE(bufoff, gbase, voff) do { _Pragma("unroll") for (int _i = 0; _i < 2; ++_i) { unsigned _keep; \
        asm volatile("s_mov_b32 %0, m0\n\ts_mov_b32 m0, %3\n\ts_nop 0\n\tglobal_load_lds_dwordx4 %1, %2\n\ts_mov_b32 m0, %0" : "=&s"(_keep) : "v"((voff)[_i]), "s"((const char*)(gbase)), "s"(ldsbase + (unsigned)(bufoff) + ldsw + (unsigned)(_i * 8192)) : "memory"); } } while (0)
#define PG8_LDA(dst, b, h) do { _Pragma("unroll") for (int m = 0; m < 4; ++m) _Pragma("unroll") for (int k = 0; k < 2; ++k) dst[m][k] = *(const LAS bf16x8*)(lds + PG8_SA(b, h) + aoff + m * 2048 + k * 1024); } while (0)
#define PG8_LDB(dst, b, h) do { _Pragma("unroll") for (int n = 0; n < 2; ++n) _Pragma("unroll") for (int k = 0; k < 2; ++k) dst[n][k] = *(const LAS bf16x8*)(lds + PG8_SB(b, h) + boff + n * 2048 + k * 1024); } while (0)
#define PG8_MMA(ai, bj, At, Bt) do { __builtin_amdgcn_s_setprio(1); _Pragma("unroll") for (int m = 0; m < 4; ++m) _Pragma("unroll") for (int n = 0; n < 2; ++n) _Pragma("unroll") for (int k = 0; k < 2; ++k) \
        acc[ai][bj][m][n] = __builtin_amdgcn_mfma_f32_16x16x32_bf16(Bt[n][k], At[m][k], acc[ai][bj][m][n], 0, 0, 0); __builtin_amdgcn_s_setprio(0); } while (0)
#define PG8_WAIT_V(n) asm volatile("s_waitcnt vmcnt(" #n ")" ::: "memory")
#define PG8_WAIT_L(n) asm volatile("s_waitcnt lgkmcnt(" #n ")" ::: "memory")
#define PG8_BAR __builtin_amdgcn_s_barrier()
#define PG8_SCHED __builtin_amdgcn_sched_barrier(0)
    Unit cur, nxt; int ui = 0;
    if (!S.next(0, cur)) return;
    f32x4 acc[2][2][4][2];
#pragma unroll
    for (int a = 0; a < 2; ++a)
#pragma unroll
        for (int b = 0; b < 2; ++b)
#pragma unroll
            for (int m = 0; m < 4; ++m)
#pragma unroll
                for (int n = 0; n < 2; ++n) acc[a][b][m][n] = (f32x4){0.f, 0.f, 0.f, 0.f};
    bf16x8 At[4][2], B0[2][2], B1[2][2];
    const char* cA = (const char*)g.A + a_off<MODE>(g, cur); const char* cB = (const char*)g.Bt + (size_t)cur.pn * tstepB;
    PG8_STAGE(PG8_SB(0, 0), cB, voffB); PG8_STAGE(PG8_SB(0, 1), cB + hstepB, voffB); PG8_STAGE(PG8_SA(0, 0), cA, voffA); PG8_STAGE(PG8_SA(0, 1), cA + hstepA, voffA);
    if (wr == 1) PG8_BAR;
    PG8_WAIT_V(2); PG8_BAR;
    PG8_STAGE(PG8_SB(1, 0), cB + kstep, voffB); PG8_STAGE(PG8_SA(1, 0), cA + kstep, voffA); PG8_STAGE(PG8_SB(1, 1), cB + hstepB + kstep, voffB);
    PG8_WAIT_V(6); PG8_BAR;
    for (;;) {
        const bool has_next = S.next(ui + 1, nxt);
        const char* nA = has_next ? (const char*)g.A + a_off<MODE>(g, nxt) : cA; const char* nB = has_next ? (const char*)g.Bt + (size_t)nxt.pn * tstepB : cB;
        for (int t = 0; t < nt; t += 2) {
            const bool last = (t == nt - 2);
            const char* a1 = cA + (size_t)(t + 1) * kstep;
            const char* a2 = last ? nA : cA + (size_t)(t + 2) * kstep; const char* b2 = last ? nB : cB + (size_t)(t + 2) * kstep;
            const char* a3 = a2 + kstep; const char* b3 = b2 + kstep;
            PG8_LDB(B0, 0, 0); PG8_LDB(B1, 0, 1); PG8_SCHED; PG8_LDA(At, 0, 0); PG8_STAGE(PG8_SA(1, 1), a1 + hstepA, voffA);
            PG8_WAIT_V(8); PG8_WAIT_L(0); PG8_BAR; PG8_MMA(0, 0, At, B0); PG8_MMA(0, 1, At, B1); PG8_BAR; PG8_SCHED;
            PG8_LDA(At, 0, 1); PG8_STAGE(PG8_SB(0, 0), b2, voffB); PG8_STAGE(PG8_SB(0, 1), b2 + hstepB, voffB); PG8_STAGE(PG8_SA(0, 0), a2, voffA);
            PG8_WAIT_V(8); PG8_WAIT_L(0); PG8_BAR; PG8_MMA(1, 0, At, B0); PG8_MMA(1, 1, At, B1); PG8_BAR; PG8_SCHED;
            PG8_LDB(B0, 1, 0); PG8_LDB(B1, 1, 1); PG8_SCHED; PG8_LDA(At, 1, 0); PG8_STAGE(PG8_SA(0, 1), a2 + hstepA, voffA);
            PG8_WAIT_V(8); PG8_WAIT_L(0); PG8_BAR; PG8_MMA(0, 0, At, B0); PG8_MMA(0, 1, At, B1); PG8_BAR; PG8_SCHED;
            PG8_LDA(At, 1, 1); PG8_STAGE(PG8_SB(1, 0), b3, voffB); PG8_STAGE(PG8_SB(1, 1), b3 + hstepB, voffB); PG8_STAGE(PG8_SA(1, 0), a3, voffA);
            PG8_WAIT_V(8); PG8_WAIT_L(0); PG8_BAR; PG8_MMA(1, 0, At, B0); PG8_MMA(1, 1, At, B1); PG8_BAR; PG8_SCHED;
        }
        if (wr == 0) PG8_BAR;
        { int l2; asm volatile("v_mbcnt_lo_u32_b32 %0, -1, 0\n\tv_mbcnt_hi_u32_b32 %0, -1, %0" : "=v"(l2));
          E(acc, cur, wr, wc, l2 & 15, l2 >> 4, xl, l2); }
        if (!has_next) break;
#pragma unroll
        for (int a = 0; a < 2; ++a)
#pragma unroll
            for (int b = 0; b < 2; ++b)
#pragma unroll
                for (int m = 0; m < 4; ++m)
#pragma unroll
                    for (int n = 0; n < 2; ++n) acc[a][b][m][n] = (f32x4){0.f, 0.f, 0.f, 0.f};
        cur = nxt; cA = nA; cB = nB; ++ui;
        if (wr == 1) PG8_BAR;
    }
    PG8_WAIT_V(0);
    PG8_BAR;
#undef PG8_SA
#undef PG8_SB
#undef PG8_STAGE
#undef PG8_LDA
#undef PG8_LDB
#undef PG8_MMA
#undef PG8_WAIT_V
#undef PG8_WAIT_L
#undef PG8_BAR
#undef PG8_SCHED
}
}

namespace att {
constexpr int NW = 8, QBLK = 32, KVBLK = 64, QB = 256;
constexpr int QP = 1536, KP = 2048, KRP = 64, VP = 2048, OP = 1024;
constexpr int KROWB = 272, KRROWB = 144;
constexpr int SHM_V = 16384, SHM_K = 64 * KROWB, SHM_KR = 64 * KRROWB;
constexpr int OFF_V = 0, OFF_K = 2 * SHM_V, OFF_KR = OFF_K + 2 * SHM_K, OFF_WS = OFF_KR + 2 * SHM_KR, OFF_QR = OFF_WS + NW * 256, NQREG = 8, NQLDS = 12 - NQREG, ATT_LDS = OFF_QR + NW * NQLDS * 1024;
static_assert(ATT_LDS <= LDS_BYTES, "attention LDS");
constexpr float SCALE = 0.07216878364870323f;
constexpr float THR = 8.f;
#define KSWZ(row, colB) ((row) * KROWB + (colB))
#define KRSWZ(row, colB) ((row) * KRROWB + (colB))
#define SBAR() __builtin_amdgcn_sched_barrier(0)
__device__ __forceinline__ int v_st(int k, int c) { const int kk = (k & ~0xC) | ((k & 4) << 1) | ((k & 8) >> 1); return ((kk >> 3) * 4 + (c >> 5)) * 512 + ((kk & 7) * 32 + (c & 31)) * 2; }
__device__ __forceinline__ int v_rd_base(int lane) { return ((lane & 3) << 3) | (((lane >> 2) & 3) << 6) | (((lane >> 4) & 1) << 5) | (((lane >> 5) & 1) << 8); }
constexpr int v_rd_off(int d0, int ks, int half) { return d0 * 512 + ks * 4096 + half * 2048; }
__device__ __forceinline__ int crow(int r, int hi) { return (r & 3) + 8 * (r >> 2) + 4 * hi; }
__device__ __forceinline__ bf16x8 ld8(const bf16_t* p) { return *reinterpret_cast<const bf16x8*>(p); }
__device__ __forceinline__ void mask_tile(f32x16& p0, f32x16& p1, int dq) {
    const float NEG = -__builtin_inff();
#pragma unroll
    for (int r = 0; r < 16; ++r) {
        const int c = (r & 3) + 8 * (r >> 2);
        if (dq - c < 0) p0[r] = NEG;
        if (dq - c - 32 < 0) p1[r] = NEG;
    }
}
__device__ __forceinline__ void partialSM(f32x16& p0, f32x16& p1, float& m_reg, float& mn, float& alpha) {
    float pmax = p0[0];
#pragma unroll
    for (int r = 1; r < 16; ++r) pmax = fmaxf(pmax, p0[r]);
#pragma unroll
    for (int r = 0; r < 16; ++r) pmax = fmaxf(pmax, p1[r]);
    { unsigned r0, r1; swap32_self(__float_as_uint(pmax), r0, r1); pmax = fmaxf(__uint_as_float(r0), __uint_as_float(r1)); }
    constexpr float C2 = 1.4426950408889634f * SCALE;
    if (__builtin_expect(__all((pmax - m_reg) * SCALE <= THR), 1)) { mn = m_reg; alpha = 1.f; }
    else { mn = fmaxf(m_reg, pmax); alpha = __builtin_amdgcn_exp2f((m_reg - mn) * C2); m_reg = mn; }
    const float mnL = -mn * C2;
#pragma unroll
    for (int r = 0; r < 16; ++r) p0[r] = fmaf(p0[r], C2, mnL);
#pragma unroll
    for (int r = 0; r < 16; ++r) p1[r] = fmaf(p1[r], C2, mnL);
#pragma unroll
    for (int r = 0; r < 16; ++r) p0[r] = __builtin_amdgcn_exp2f(p0[r]);
}
__device__ __forceinline__ void finishSM(f32x16& p0, f32x16& p1, float alpha, float& l_reg, bf16x8& pa0, bf16x8& pa1, bf16x8& pa2, bf16x8& pa3) {
#pragma unroll
    for (int r = 0; r < 16; ++r) p1[r] = __builtin_amdgcn_exp2f(p1[r]);
    float ps = 0;
#pragma unroll
    for (int r = 0; r < 16; ++r) ps += p0[r];
#pragma unroll
    for (int r = 0; r < 16; ++r) ps += p1[r];
    { unsigned r0, r1; swap32_self(__float_as_uint(ps), r0, r1); ps = __uint_as_float(r0) + __uint_as_float(r1); }
    l_reg = l_reg * alpha + ps;
#define PK4(P, B_, OUT) do { unsigned a0 = cvt_pk_bf16(P[B_+0], P[B_+1]), a1 = cvt_pk_bf16(P[B_+2], P[B_+3]);                          \
        unsigned b0 = cvt_pk_bf16(P[B_+4], P[B_+5]), b1 = cvt_pk_bf16(P[B_+6], P[B_+7]);                                             \
        auto r0 = __builtin_amdgcn_permlane32_swap(a0, b0, false, false); auto r1 = __builtin_amdgcn_permlane32_swap(a1, b1, false, false); \
        u32x4 w = {r0[0], r1[0], r0[1], r1[1]}; OUT = *reinterpret_cast<bf16x8*>(&w); } while (0)
    PK4(p0, 0, pa0); PK4(p0, 8, pa1); PK4(p1, 0, pa2); PK4(p1, 8, pa3);
#undef PK4
}
template <int KB>
__device__ __forceinline__ void qkt(f32x16& p0, f32x16& p1, const char* lds, int r32, int hi, const bf16x8* qr, const LAS char* qrl) {
    p0 = f32x16{}; p1 = f32x16{};
    const char* kb = lds + OFF_K + KB * SHM_K + KSWZ(r32, hi * 16); const char* kr = lds + OFF_KR + KB * SHM_KR + KRSWZ(r32, hi * 16);
#pragma unroll
    for (int d0 = 0; d0 < NQREG; ++d0) {
        bf16x8 b0 = *reinterpret_cast<const bf16x8*>(kb + d0 * 32);
        bf16x8 b1 = *reinterpret_cast<const bf16x8*>(kb + d0 * 32 + 32 * KROWB);
        p0 = __builtin_amdgcn_mfma_f32_32x32x16_bf16(b0, qr[d0], p0, 0, 0, 0);
        p1 = __builtin_amdgcn_mfma_f32_32x32x16_bf16(b1, qr[d0], p1, 0, 0, 0); }
#pragma unroll
    for (int d0 = NQREG; d0 < 8; ++d0) {
        bf16x8 b0 = *reinterpret_cast<const bf16x8*>(kb + d0 * 32);
        bf16x8 b1 = *reinterpret_cast<const bf16x8*>(kb + d0 * 32 + 32 * KROWB);
        const bf16x8 qf = *(const volatile LAS bf16x8*)(qrl + (d0 - NQREG) * 1024);
        p0 = __builtin_amdgcn_mfma_f32_32x32x16_bf16(b0, qf, p0, 0, 0, 0);
        p1 = __builtin_amdgcn_mfma_f32_32x32x16_bf16(b1, qf, p1, 0, 0, 0); }
#pragma unroll
    for (int dd = 0; dd < 4; ++dd) {
        bf16x8 b0 = *reinterpret_cast<const bf16x8*>(kr + dd * 32);
        bf16x8 b1 = *reinterpret_cast<const bf16x8*>(kr + dd * 32 + 32 * KRROWB);
        const bf16x8 qf = *(const volatile LAS bf16x8*)(qrl + (8 + dd - NQREG) * 1024);
        p0 = __builtin_amdgcn_mfma_f32_32x32x16_bf16(b0, qf, p0, 0, 0, 0);
        p1 = __builtin_amdgcn_mfma_f32_32x32x16_bf16(b1, qf, p1, 0, 0, 0); }
}
template <int VB>
__device__ __forceinline__ void pv_tile(f32x16* o, int vb0, bf16x8 pa0, bf16x8 pa1, bf16x8 pa2, bf16x8 pa3) {
#define TRRD(dst, off) asm volatile("ds_read_b64_tr_b16 %0, %1 offset:%2" : "=&v"(dst) : "v"(vb0), "i"(off) : "memory")
#define PV_D0(d0) do { s16x4 l0, l1, l2, l3, h0, h1, h2, h3; constexpr int b_ = OFF_V + VB * SHM_V + v_rd_off(d0, 0, 0); \
        TRRD(l0, b_); TRRD(h0, b_ + 2048); TRRD(l1, b_ + 4096); TRRD(h1, b_ + 6144); TRRD(l2, b_ + 8192); TRRD(h2, b_ + 10240); TRRD(l3, b_ + 12288); TRRD(h3, b_ + 14336); \
        asm volatile("s_waitcnt lgkmcnt(0)" ::: "memory"); SBAR();   \
        o[d0] = __builtin_amdgcn_mfma_f32_32x32x16_bf16(pa0, (bf16x8){l0[0], l0[1], l0[2], l0[3], h0[0], h0[1], h0[2], h0[3]}, o[d0], 0, 0, 0);   \
        o[d0] = __builtin_amdgcn_mfma_f32_32x32x16_bf16(pa1, (bf16x8){l1[0], l1[1], l1[2], l1[3], h1[0], h1[1], h1[2], h1[3]}, o[d0], 0, 0, 0);   \
        o[d0] = __builtin_amdgcn_mfma_f32_32x32x16_bf16(pa2, (bf16x8){l2[0], l2[1], l2[2], l2[3], h2[0], h2[1], h2[2], h2[3]}, o[d0], 0, 0, 0);   \
        o[d0] = __builtin_amdgcn_mfma_f32_32x32x16_bf16(pa3, (bf16x8){l3[0], l3[1], l3[2], l3[3], h3[0], h3[1], h3[2], h3[3]}, o[d0], 0, 0, 0); } while (0)
    PV_D0(0); PV_D0(1); PV_D0(2); PV_D0(3);
#undef PV_D0
#undef TRRD
}
struct BlockRef { const bf16_t* Q; const bf16_t* K; const bf16_t* KR; const bf16_t* V; bf16_t* O; int P0; };
#define VMW() asm volatile("s_waitcnt vmcnt(0)" ::: "memory")
#define GLD8(base, soff, voff) (*(const __attribute__((address_space(1))) bf16x8*)((const __attribute__((address_space(1))) char*)(base) + (size_t)(soff) + (voff)))
#define LOADK(k0) do { st_k0 = GLD8(cur.K, (size_t)(k0) * (KP * 2), kvoff); st_k1 = GLD8(cur.K, (size_t)((k0) + 32) * (KP * 2), kvoff);   \
                       st_kr = GLD8(cur.KR, (size_t)(k0) * (KRP * 2), krvoff); } while (0)
#define LOADV(k0) do { st_v0 = GLD8(cur.V, (size_t)(k0) * (VP * 2), kvoff); st_v1 = GLD8(cur.V, (size_t)((k0) + 32) * (VP * 2), kvoff); } while (0)
#define WRITEK(bf) do { *(bf16x8*)(lds + OFF_K + (bf) * SHM_K + kws) = st_k0; *(bf16x8*)(lds + OFF_K + (bf) * SHM_K + kws + 32 * KROWB) = st_k1; \
                        *(bf16x8*)(lds + OFF_KR + (bf) * SHM_KR + krws) = st_kr; } while (0)
#define WRITEV(bf) do { *(bf16x8*)(lds + OFF_V + (bf) * SHM_V + vst0) = st_v0; *(bf16x8*)(lds + OFF_V + (bf) * SHM_V + vst1) = st_v1; } while (0)
#define ABAR() do { asm volatile("s_waitcnt lgkmcnt(0)" ::: "memory"); __builtin_amdgcn_s_barrier(); asm volatile("" ::: "memory"); } while (0)
__device__ __forceinline__ void block(const BlockRef& cur, char* lds, const int tid) {
    const int wid = __builtin_amdgcn_readfirstlane(tid >> 6), lane = tid & 63, r32 = lane & 31, hi = lane >> 5, grp = wid >> 2;
    const int NT = (cur.P0 + QB) / KVBLK;
    const int qlo = cur.P0 + wid * QBLK, qm = qlo + r32 - 4 * hi;
    float* ws = (float*)(lds + OFF_WS) + wid * 64; float* li_l = ws, * al_l = ws + 32;
    float m_reg = -1e30f, l_reg = 0; f32x16 o[4] = {};
    const int sr = tid >> 4, sc = (tid & 15) * 8, vst0 = v_st(sr, sc), vst1 = v_st(32 + sr, sc), kws = KSWZ(sr, sc * 2);
    const int krr = tid >> 3, krc = (tid & 7) * 8, krws = KRSWZ(krr, krc * 2);
    const unsigned kvoff = (unsigned)(sr * KP + sc) * 2u, krvoff = (unsigned)(krr * KRP + krc) * 2u, qvoff = (unsigned)((wid * QBLK + r32) * QP + hi * 8) * 2u;
    const int vb0 = (int)(uintptr_t)lds + v_rd_base(lane);
    LAS char* qrl = (LAS char*)lds + OFF_QR + wid * (NQLDS * 1024) + lane * 16;
    bf16x8 qr[NQREG]; bf16x8 st_v0, st_v1, st_k0, st_k1, st_kr;
#pragma unroll
    for (int d0 = 0; d0 < NQREG; ++d0) qr[d0] = GLD8(cur.Q, d0 * 32, qvoff);
#pragma unroll
    for (int dd = 0; dd < NQLDS; ++dd) { const bf16x8 tq = GLD8(cur.Q, (NQREG + dd) * 32, qvoff); *(volatile LAS bf16x8*)(qrl + dd * 1024) = tq; }
    LOADK(0); VMW(); WRITEK(0);
    LOADK(KVBLK); LOADV(0);
    ABAR();
    if (grp) ABAR();
#define RESC(a) do { if (__any((a) < 1.f)) { if (hi == 0) al_l[r32] = (a); asm volatile("s_waitcnt lgkmcnt(0)" ::: "memory");              \
                     for (int d_ = 0; d_ < 4; ++d_) for (int r = 0; r < 16; ++r) o[d_][r] *= al_l[crow(r, hi)]; } } while (0)
#define KBASE(t) ((t) * KVBLK)
#define MASKT(P0_, P1_, t) do { const int kb_ = KBASE(t); if (kb_ + KVBLK - 1 > qlo) mask_tile(P0_, P1_, qm - kb_); } while (0)
    f32x16 p0, p1; bf16x8 pa0, pa1, pa2, pa3;
#define STEP(t, KB) do { float mn, al;                                                                                         \
        SBAR(); qkt<KB>(p0, p1, lds, r32, hi, qr, qrl);                                                                        \
        if ((t) > 0) pv_tile<(KB) ^ 1>(o, vb0, pa0, pa1, pa2, pa3);                                                            \
        SBAR(); VMW(); if ((t) + 1 < NT) WRITEK((KB) ^ 1); WRITEV(KB);        \
        if ((t) + 2 < NT) LOADK(KBASE((t) + 2)); if ((t) + 1 < NT) LOADV(KBASE((t) + 1));                                      \
        ABAR();                                                                                                                \
        MASKT(p0, p1, (t)); partialSM(p0, p1, m_reg, mn, al); RESC(al);                                                        \
        finishSM(p0, p1, al, l_reg, pa0, pa1, pa2, pa3);                                                                       \
        ABAR(); } while (0)
    for (int t = 0; t < NT; t += 2) { STEP(t, 0); STEP(t + 1, 1); }
    pv_tile<1>(o, vb0, pa0, pa1, pa2, pa3);
    if (!grp) ABAR();
    if (hi == 0) li_l[r32] = l_reg; asm volatile("s_waitcnt lgkmcnt(0)" ::: "memory");
    float rli[16];
#pragma unroll
    for (int r = 0; r < 16; ++r) rli[r] = __builtin_amdgcn_rcpf(li_l[crow(r, hi)]);
    bf16_t* Ow = cur.O + (size_t)(wid * QBLK) * OP;
#pragma unroll
    for (int r = 0; r < 16; ++r) { const int orow = crow(r, hi);
#pragma unroll
        for (int d0 = 0; d0 < 4; ++d0) { const float v = o[d0][r] * rli[r];
            const float vn = DPPF(v, 0xB1);
            if ((r32 & 1) == 0) *(unsigned*)(Ow + (size_t)orow * OP + d0 * 32 + r32) = cvt_pk_bf16(v, vn); } }
    ABAR();
#undef RESC
#undef KBASE
#undef MASKT
#undef STEP
}
#undef LOADK
#undef LOADV
#undef WRITEK
#undef WRITEV
#undef GLD8
__device__ __forceinline__ BlockRef mkref(int bh, int qb, const bf16_t* Q, const bf16_t* KV, const bf16_t* KR, bf16_t* O) {
    const int b = bh >> 3, h = bh & 7; BlockRef r;
    r.Q = Q + (size_t)(b * SEQ + qb * QB) * QP + h * 192; r.K = KV + (size_t)b * SEQ * KP + h * 128; r.KR = KR + (size_t)b * SEQ * KRP;
    r.V = KV + (size_t)b * SEQ * VP + 1024 + h * 128; r.O = O + (size_t)(b * SEQ + qb * QB) * OP + h * 128; r.P0 = qb * QB; return r;
}
__device__ __forceinline__ void attn_phase(char* lds, const bf16_t* Q, const bf16_t* KV, const bf16_t* KR, bf16_t* O, const int tid, const int bid) {
    for (int L = bid; L < 512; L += gridDim.x) {
        const int bh = (L >> 6) * 8 + (L & 7), x = (L >> 3) & 7;
        for (int pass = 0; pass < 2; ++pass) { const BlockRef cur = mkref(bh, pass ? x : 15 - x, Q, KV, KR, O); block(cur, lds, tid); }
    }
}
}

__device__ __forceinline__ void norm_rows(const float* x, const float* g1, const float* mods_l, int shi, int sci, bf16_t* o1, const float* g2, bf16_t* o2, int gw, int NGW, int lane) {
    f32x4 nx[4];
    if (gw < MT) { const f32x4* xr = (const f32x4*)(x + (size_t)gw * DM) + lane;
#pragma unroll
        for (int j = 0; j < 4; ++j) nx[j] = xr[64 * j]; }
    for (int m = gw; m < MT; m += NGW) {
        const int b = m >> 12;
        f32x4 v[4]; float s = 0.f;
#pragma unroll
        for (int j = 0; j < 4; ++j) v[j] = nx[j];
        if (m + NGW < MT) { const f32x4* xr = (const f32x4*)(x + (size_t)(m + NGW) * DM) + lane;
#pragma unroll
            for (int j = 0; j < 4; ++j) nx[j] = xr[64 * j]; }
#pragma unroll
        for (int j = 0; j < 4; ++j) s += (v[j].x * v[j].x + v[j].y * v[j].y) + (v[j].z * v[j].z + v[j].w * v[j].w);
        const float rstd = rsqrtf(wave_sum(s) * (1.f / DM) + EPS);
#pragma unroll
        for (int j = 0; j < 4; ++j) { const int col = 4 * lane + 256 * j; const f32x4 y = v[j] * rstd;
            f32x4 h = y * *(const f32x4*)(g1 + col);
            if (mods_l) { const f32x4 scv = *(const f32x4*)(mods_l + b * 6144 + sci * 1024 + col), shv = *(const f32x4*)(mods_l + b * 6144 + shi * 1024 + col); h = h * (scv + 1.0f) + shv; }
            u32x2 w; w.x = pk2(h.x, h.y); w.y = pk2(h.z, h.w); *(u32x2*)(o1 + (size_t)m * DM + col) = w;
            if (o2) { const f32x4 k = y * *(const f32x4*)(g2 + col); u32x2 w2; w2.x = pk2(k.x, k.y); w2.y = pk2(k.z, k.w); *(u32x2*)(o2 + (size_t)m * DM + col) = w2; } }
    }
}
__device__ __forceinline__ void norm_rows_b(const bf16_t* x, const float* g1, const float* mods_l, int shi, int sci, bf16_t* o1, const float* g2, bf16_t* o2, int gw, int NGW, int lane) {
    u32x4 nx[2];
    if (gw < MT) { const u32x4* xr = (const u32x4*)(x + (size_t)gw * DM) + lane; nx[0] = xr[0]; nx[1] = xr[64]; }
    for (int m = gw; m < MT; m += NGW) {
        const int b = m >> 12;
        u32x4 raw[2] = {nx[0], nx[1]};
        if (m + NGW < MT) { const u32x4* xr = (const u32x4*)(x + (size_t)(m + NGW) * DM) + lane; nx[0] = xr[0]; nx[1] = xr[64]; }
        float v[2][8]; float s = 0.f;
#pragma unroll
        for (int j = 0; j < 2; ++j)
#pragma unroll
            for (int q = 0; q < 4; ++q) { v[j][2 * q] = bflo(raw[j][q]); v[j][2 * q + 1] = bfhi(raw[j][q]); s += v[j][2 * q] * v[j][2 * q] + v[j][2 * q + 1] * v[j][2 * q + 1]; }
        const float rstd = rsqrtf(wave_sum(s) * (1.f / DM) + EPS);
#pragma unroll
        for (int j = 0; j < 2; ++j) { const int col = 8 * lane + 512 * j;
            const f32x4 ga = *(const f32x4*)(g1 + col), gb = *(const f32x4*)(g1 + col + 4);
            f32x4 ya = (f32x4){v[j][0], v[j][1], v[j][2], v[j][3]} * rstd, yb = (f32x4){v[j][4], v[j][5], v[j][6], v[j][7]} * rstd;
            f32x4 ha = ya * ga, hb = yb * gb;
            if (mods_l) { const float* sp = mods_l + b * 6144 + sci * 1024 + col; const float* hp = mods_l + b * 6144 + shi * 1024 + col;
                ha = ha * (*(const f32x4*)sp + 1.0f) + *(const f32x4*)hp; hb = hb * (*(const f32x4*)(sp + 4) + 1.0f) + *(const f32x4*)(hp + 4); }
            u32x4 w; w.x = pk2(ha.x, ha.y); w.y = pk2(ha.z, ha.w); w.z = pk2(hb.x, hb.y); w.w = pk2(hb.z, hb.w); *(u32x4*)(o1 + (size_t)m * DM + col) = w;
            if (o2) { const f32x4 ka = ya * *(const f32x4*)(g2 + col), kb = yb * *(const f32x4*)(g2 + col + 4);
                u32x4 w2; w2.x = pk2(ka.x, ka.y); w2.y = pk2(ka.z, ka.w); w2.z = pk2(kb.x, kb.y); w2.w = pk2(kb.z, kb.w); *(u32x4*)(o2 + (size_t)m * DM + col) = w2; } }
    }
}
__device__ __forceinline__ void ld8f(const bf16_t* p, float* v) { const u32x4 u = *(const u32x4*)p;
#pragma unroll
    for (int q = 0; q < 4; ++q) { v[2 * q] = bflo(u[q]); v[2 * q + 1] = bfhi(u[q]); } }
__device__ __forceinline__ void pooled_phase(const bf16_t* h, bf16_t* out, int gtid, int NT_) {
    for (int job = gtid; job < (MT / 32) * 128; job += NT_) {
        const int col = (job & 127) * 8, row0 = (job >> 7) * 32, w = 2 << (col >> 8), t0 = row0 & (SEQ - 1);
        const bf16_t* hp = h + (size_t)row0 * DM + col; bf16_t* op = out + (size_t)row0 * DM + col;
        float s[8];
#pragma unroll
        for (int q = 0; q < 8; ++q) s[q] = 0.f;
        const int nwarm = (t0 < w) ? t0 : w;
        for (int k = 1; k <= nwarm; ++k) { float v[8]; ld8f(hp - (size_t)k * DM, v);
#pragma unroll
            for (int q = 0; q < 8; ++q) s[q] += v[q]; }
#pragma unroll 4
        for (int r = 0; r < 32; ++r) { const int t = t0 + r; float cur[8]; ld8f(hp + (size_t)r * DM, cur);
#pragma unroll
            for (int q = 0; q < 8; ++q) s[q] += cur[q];
            if (t >= w) { float old[8]; ld8f(hp + (size_t)(r - w) * DM, old);
#pragma unroll
                for (int q = 0; q < 8; ++q) s[q] -= old[q]; }
            const float inv = 1.0f / (float)((t + 1 < w) ? t + 1 : w);
            u32x4 o;
#pragma unroll
            for (int q = 0; q < 4; ++q) o[q] = pk2(s[2 * q] * inv - cur[2 * q], s[2 * q + 1] * inv - cur[2 * q + 1]);
            *(u32x4*)(op + (size_t)r * DM) = o; }
    }
}
__device__ __forceinline__ void cq_norm(const bf16_t* raw, const float* g, bf16_t* out, int gw, int NGW, int lane) {
    u32x2 na = {0u, 0u}, nc = {0u, 0u};
    if (gw < MT) { const bf16_t* r = raw + (size_t)gw * 512; na = *(const u32x2*)(r + 4 * lane); if (lane < 32) nc = *(const u32x2*)(r + 256 + 4 * lane); }
    for (int m = gw; m < MT; m += NGW) {
        const u32x2 a = na, c = nc;
        if (m + NGW < MT) { const bf16_t* r = raw + (size_t)(m + NGW) * 512; na = *(const u32x2*)(r + 4 * lane); if (lane < 32) nc = *(const u32x2*)(r + 256 + 4 * lane); }
        float v[8] = {bflo(a.x), bfhi(a.x), bflo(a.y), bfhi(a.y), bflo(c.x), bfhi(c.x), bflo(c.y), bfhi(c.y)};
        float s = 0.f;
#pragma unroll
        for (int q = 0; q < 8; ++q) s += v[q] * v[q];
        const float rstd = rsqrtf(wave_sum(s) * (1.f / 384.f) + EPS);
        const f32x4 g0 = *(const f32x4*)(g + 4 * lane);
        u32x2 w; w.x = pk2(v[0] * rstd * g0.x, v[1] * rstd * g0.y); w.y = pk2(v[2] * rstd * g0.z, v[3] * rstd * g0.w);
        *(u32x2*)(out + (size_t)m * 384 + 4 * lane) = w;
        if (lane < 32) { const f32x4 g1 = *(const f32x4*)(g + 256 + 4 * lane); u32x2 w2; w2.x = pk2(v[4] * rstd * g1.x, v[5] * rstd * g1.y); w2.y = pk2(v[6] * rstd * g1.z, v[7] * rstd * g1.w);
            *(u32x2*)(out + (size_t)m * 384 + 256 + 4 * lane) = w2; }
    }
}
__device__ __forceinline__ void ckv_norm(const bf16_t* raw, const float* g, const float* cs, bf16_t* ckv, bf16_t* kr, int gw, int NGW, int lane) {
    u32x2 na = {0u, 0u}; unsigned np = 0u; f32x2 ncs = {0.f, 0.f};
    if (gw < MT) { const bf16_t* r = raw + (size_t)gw * 512; na = *(const u32x2*)(r + 4 * lane); if (lane < 32) { np = *(const unsigned*)(r + 256 + 2 * lane); ncs = *(const f32x2*)(cs + (size_t)gw * 64 + 2 * lane); } }
    for (int m = gw; m < MT; m += NGW) {
        const u32x2 a = na; const unsigned p = np; const f32x2 c = ncs;
        if (m + NGW < MT) { const bf16_t* r = raw + (size_t)(m + NGW) * 512; na = *(const u32x2*)(r + 4 * lane); if (lane < 32) { np = *(const unsigned*)(r + 256 + 2 * lane); ncs = *(const f32x2*)(cs + (size_t)(m + NGW) * 64 + 2 * lane); } }
        const float v0 = bflo(a.x), v1 = bfhi(a.x), v2 = bflo(a.y), v3 = bfhi(a.y);
        const float rstd = rsqrtf(wave_sum(v0 * v0 + v1 * v1 + v2 * v2 + v3 * v3) * (1.f / 256.f) + EPS);
        const f32x4 g0 = *(const f32x4*)(g + 4 * lane);
        u32x2 w; w.x = pk2(v0 * rstd * g0.x, v1 * rstd * g0.y); w.y = pk2(v2 * rstd * g0.z, v3 * rstd * g0.w);
        *(u32x2*)(ckv + (size_t)m * 256 + 4 * lane) = w;
        if (lane < 32) { const float x1 = bflo(p), x2 = bfhi(p);
            *(unsigned*)(kr + (size_t)m * 64 + 2 * lane) = pk2(x1 * c.x - x2 * c.y, x2 * c.x + x1 * c.y); }
    }
}
__device__ __forceinline__ int col_map(int kind, int n) {
    if (kind == 0) return n;
    if (kind == 1) { const int pn = n >> 8, r = n & 255; return (r >> 7) * FF + 128 * pn + (r & 127); }
    if (kind == 2) { if (n < 256) return n; if (n < 320) { const int i = n - 256; return 256 + (i >> 1) + (i & 1) * 32; } return -1; }
    if (kind == 3) { const int h = n / 192, r = n - h * 192; if (r < 128) return n; const int i = r - 128; return h * 192 + 128 + (i >> 1) + (i & 1) * 32; }
    return n < 384 ? n : -1;
}
__device__ __forceinline__ void tr_item(const float* W, int K, int N, bf16_t* WT, int nblk, int kind, LAS float* scr, int item, int lane) {
    const int kb = item / nblk, nb = item - kb * nblk, k0 = 64 * kb, n0 = 32 * nb;
    const int src = col_map(kind, n0 + (lane & 31));
#pragma unroll
    for (int i = 0; i < 32; ++i) { const int kk = 2 * i + (lane >> 5); scr[kk * 33 + (lane & 31)] = src >= 0 ? W[(size_t)(k0 + kk) * N + src] : 0.f; }
    LDS_WAIT(); asm volatile("" ::: "memory");
    const int c = lane & 7;
#pragma unroll
    for (int j = 0; j < 4; ++j) { const int n = (lane >> 3) + 8 * j; const LAS float* s = scr + (8 * c) * 33 + n;
        u32x4 o; o.x = pk2(s[0 * 33], s[1 * 33]); o.y = pk2(s[2 * 33], s[3 * 33]); o.z = pk2(s[4 * 33], s[5 * 33]); o.w = pk2(s[6 * 33], s[7 * 33]);
        *(u32x4*)(WT + (size_t)(n0 + n) * K + k0 + 8 * c) = o; }
    LDS_WAIT(); asm volatile("" ::: "memory");
}
struct Seg { const float* W; bf16_t* WT; int K, N, Nout, kind; };
__device__ __forceinline__ Seg get_seg(ArgsP a, int s) {
    unsigned char* ws = a->ws; ASSUME_GLOBAL(ws); Seg g;
    if (s < 4) { g.W = AF(w_up) + (size_t)s * 1024 * 5632; g.WT = (bf16_t*)(ws + WS_WUP); g.K = 1024; g.N = 5632; g.Nout = 5632; g.kind = 1; }
    else if (s < 8) { const int l = s - 4; g.W = AF(w_down) + (size_t)l * FF * 1024; g.WT = (bf16_t*)(ws + WS_WDN); g.K = FF; g.N = 1024; g.Nout = 1024; g.kind = 0; }
    else if (s < 16) { const int i = s - 8; g.W = AF(pool_w) + (size_t)i * 65536; g.WT = (bf16_t*)(ws + WS_WPOOL) + (size_t)i * 65536; g.K = 256; g.N = 256; g.Nout = 256; g.kind = 0; }
    else if (s == 16) { g.W = AF(w_dkv); g.WT = (bf16_t*)(ws + WS_WDKV); g.K = 1024; g.N = 320; g.Nout = 512; g.kind = 2; }
    else if (s == 17) { g.W = AF(w_uk); g.WT = (bf16_t*)(ws + WS_WKV); g.K = 256; g.N = 1024; g.Nout = 1024; g.kind = 0; }
    else if (s == 18) { g.W = AF(w_uv); g.WT = (bf16_t*)(ws + WS_WKV) + (size_t)1024 * 256; g.K = 256; g.N = 1024; g.Nout = 1024; g.kind = 0; }
    else if (s < 21) { const int j = s - 19; g.W = AF(w_dq) + (size_t)j * 1024 * 384; g.WT = (bf16_t*)(ws + WS_WDQ) + (size_t)j * 512 * 1024; g.K = 1024; g.N = 384; g.Nout = 512; g.kind = 4; }
    else if (s < 23) { const int j = s - 21; g.W = AF(w_uq) + (size_t)j * 384 * 1536; g.WT = (bf16_t*)(ws + WS_WUQ + j * WUQ_SZ); g.K = 384; g.N = 1536; g.Nout = 1536; g.kind = 3; }
    else { const int j = s - 23; g.W = AF(w_o) + (size_t)j * 1024 * 1024; g.WT = (bf16_t*)(ws + WS_WO) + (size_t)j * 1024 * 1024; g.K = 1024; g.N = 1024; g.Nout = 1024; g.kind = 0; }
    return g;
}
constexpr int NSEG = 25;
__device__ __forceinline__ void prep_phase(ArgsP a, LAS unsigned char* lds, int tid, int lane, int wave, int bid) {
    unsigned char* wsp_ = a->ws; ASSUME_GLOBAL(wsp_); float* mods = (float*)(wsp_ + WS_MODS);
    LAS float* sl = (LAS float*)lds; LAS float* red = (LAS float*)(lds + 32768);
    for (int i = tid; i < NB * DM; i += NTHR) { const float v = AF(c)[i]; sl[i] = v / (1.f + __expf(-v)); }
    __syncthreads();
    for (int it = bid; it < 4 * 192; it += gridDim.x) {
        const int l = it / 192, e0 = (it - l * 192) * 32, c = lane & 31, kh = lane >> 5;
        const float* W = AF(mod_w) + (size_t)l * DM * 6144 + e0 + c;
        float acc[8];
#pragma unroll
        for (int b = 0; b < 8; ++b) acc[b] = 0.f;
        const int kbeg = wave * 128 + kh;
#pragma unroll 16
        for (int k = kbeg; k < kbeg + 128; k += 2) { const float wv = W[(size_t)k * 6144];
#pragma unroll
            for (int b = 0; b < 8; ++b) acc[b] += sl[b * DM + k] * wv; }
#pragma unroll
        for (int b = 0; b < 8; ++b) red[(wave * 8 + b) * 64 + lane] = acc[b];
        __syncthreads();
        if (tid < 256) { const int b = tid >> 5, cc = tid & 31; float s = AF(mod_b)[l * 6144 + e0 + cc];
#pragma unroll
          for (int w = 0; w < 8; ++w) s += red[(w * 8 + b) * 64 + cc] + red[(w * 8 + b) * 64 + 32 + cc];
          mods[(size_t)(l * 8 + b) * 6144 + e0 + cc] = s; }
        __syncthreads();
    }
    { float* cs = (float*)(wsp_ + WS_CS); const int gtid = bid * NTHR + tid, NT_ = gridDim.x * NTHR;
      for (int idx = gtid; idx < MT * 32; idx += NT_) { const int row = idx >> 5, i = idx & 31;
          const float inv = exp2f(-(float)i * 0.41524101186092029f);
          const double rev = (double)AI(pos)[row] * (double)inv * 0.15915494309189535; const float fr = (float)(rev - floor(rev));
          f32x2 o; o.x = __builtin_amdgcn_cosf(fr); o.y = __builtin_amdgcn_sinf(fr); *(f32x2*)(cs + (size_t)idx * 2) = o; } }
    __syncthreads();
    LAS float* scr = (LAS float*)(lds + wave * 16384);
    const int gw = bid * NWAVES + wave, NGW = gridDim.x * NWAVES;
    int base = 0;
    for (int s = 8; s < NSEG; ++s) {
        const Seg g = get_seg(a, s); const int nblk = g.Nout / 32, nit = (g.K / 64) * nblk;
        int first = (gw - base % NGW + NGW) % NGW;
        for (int it = first; it < nit; it += NGW) tr_item(g.W, g.K, g.N, g.WT, nblk, g.kind, scr, it, lane);
        base += nit;
    }
}
__device__ __forceinline__ void ffn_weights(ArgsP a, LAS unsigned char* lds, int l, int lane, int wave, int bid) {
    LAS float* scr = (LAS float*)(lds + wave * 16384);
    const int gw = bid * NWAVES + wave, NGW = gridDim.x * NWAVES;
    int base = 0;
    for (int q = 0; q < 2; ++q) {
        const Seg g = get_seg(a, q ? 4 + l : l); const int nblk = g.Nout / 32, nit = (g.K / 64) * nblk;
        int first = (gw - base % NGW + NGW) % NGW;
        for (int it = first; it < nit; it += NGW) tr_item(g.W, g.K, g.N, g.WT, nblk, g.kind, scr, it, lane);
        base += nit;
    }
}
__device__ __forceinline__ void final_norm(const bf16_t* x, float* out, const float* g, int gw, int NGW, int lane) {
    u32x4 nx[2];
    if (gw < MT) { const u32x4* xr = (const u32x4*)(x + (size_t)gw * DM) + lane; nx[0] = xr[0]; nx[1] = xr[64]; }
    for (int m = gw; m < MT; m += NGW) {
        u32x4 raw[2] = {nx[0], nx[1]};
        if (m + NGW < MT) { const u32x4* xr = (const u32x4*)(x + (size_t)(m + NGW) * DM) + lane; nx[0] = xr[0]; nx[1] = xr[64]; }
        float v[2][8]; float s = 0.f;
#pragma unroll
        for (int j = 0; j < 2; ++j)
#pragma unroll
            for (int q = 0; q < 4; ++q) { v[j][2 * q] = bflo(raw[j][q]); v[j][2 * q + 1] = bfhi(raw[j][q]); s += v[j][2 * q] * v[j][2 * q] + v[j][2 * q + 1] * v[j][2 * q + 1]; }
        const float rstd = rsqrtf(wave_sum(s) * (1.f / DM) + EPS);
#pragma unroll
        for (int j = 0; j < 2; ++j) { const int col = 8 * lane + 512 * j; float* o = out + (size_t)m * DM + col;
            *(f32x4*)o = (f32x4){v[j][0], v[j][1], v[j][2], v[j][3]} * rstd * *(const f32x4*)(g + col);
            *(f32x4*)(o + 4) = (f32x4){v[j][4], v[j][5], v[j][6], v[j][7]} * rstd * *(const f32x4*)(g + col + 4); }
    }
}


enum { K_PREP = 0, K_NORM1, K_POOLED, K_GPOOL, K_NORM2, K_GUP, K_GDOWN, K_NORMA, K_GEMMA, K_NORMB, K_GEMMB, K_ATTN, K_GWO, K_FINAL };
constexpr int NPHASE = 1 + 2 * 6 + 2 * 9 + 1;
__device__ __forceinline__ void phase_of(int ph, int& kind, int& l) {
    if (ph == 0) { kind = K_PREP; l = 0; return; }
    if (ph <= 12) { l = (ph - 1) / 6; const int k = (ph - 1) - l * 6; kind = (k == 0) ? K_NORM1 : (k == 1) ? K_POOLED : (k == 2) ? K_GPOOL : (k == 3) ? K_NORM2 : (k == 4) ? K_GUP : K_GDOWN; return; }
    if (ph <= 30) { const int q = (ph - 13) / 9, k = (ph - 13) - q * 9; l = 2 + q;
        kind = (k == 0) ? K_NORMA : (k == 1) ? K_GEMMA : (k == 2) ? K_NORMB : (k == 3) ? K_GEMMB : (k == 4) ? K_ATTN : (k == 5) ? K_GWO : (k == 6) ? K_NORM2 : (k == 7) ? K_GUP : K_GDOWN; return; }
    kind = K_FINAL; l = 3;
}


#define XB_TMO      128
#define XB_XCNT(j)  (256  + 64 * (j))
#define XB_XSUB(j)  (1280 + 64 * (j))
#define XB_XGEN(j)  (2304 + 64 * (j))
#define XB_TOP      3328
#define XB_TOPGEN   3392
#define XCD_BAR_WORDS 3456
#define XB_SPIN_CAP (1u << 22)
constexpr size_t WS_BAR = 10 * MiB;
__device__ __forceinline__ unsigned xb_ld(unsigned* p)              { return __hip_atomic_load(p, __ATOMIC_RELAXED, __HIP_MEMORY_SCOPE_AGENT); }
__device__ __forceinline__ unsigned xb_add(unsigned* p, unsigned v) { return __hip_atomic_fetch_add(p, v, __ATOMIC_RELAXED, __HIP_MEMORY_SCOPE_AGENT); }
__device__ __forceinline__ unsigned xb_xcc_id() { return (unsigned)__builtin_amdgcn_s_getreg((3 << 11) | 20) & 0xFu; }
#define XB_SPIN(cond, bar) do { unsigned _sp = 0; while (cond) { __builtin_amdgcn_s_sleep(1); \
    if ((++_sp & 255u) == 0u) { if (xb_ld(&(bar)[XB_TMO])) break; if (_sp > XB_SPIN_CAP) { atomicAdd(&(bar)[XB_TMO], 1u); break; } } } } while (0)
__device__ __forceinline__ void xcd_barrier_complete(unsigned* bar, unsigned x, unsigned& nloc, unsigned& nx) {
    const unsigned G = gridDim.x;
    unsigned sum, cnt, mine, sp = 0u;
    for (;;) {
        sum = 0u; cnt = 0u; mine = 0u;
#pragma unroll
        for (unsigned j = 0; j < 16; ++j) { const unsigned c = xb_ld(&bar[XB_XCNT(j)]); sum += c; cnt += (c > 0u) ? 1u : 0u; mine = (j == x) ? c : mine; }
        if (sum == G) break;
        __builtin_amdgcn_s_sleep(1);
        if ((++sp & 255u) == 0u) { if (xb_ld(&bar[XB_TMO])) break; if (sp > XB_SPIN_CAP) { atomicAdd(&bar[XB_TMO], 1u); break; } }
    }
    nloc = mine > 0u ? mine : 1u; nx = cnt > 0u ? cnt : 1u;
}
__device__ __forceinline__ void xcd_barrier(unsigned* bar, unsigned x, volatile LAS unsigned* st, bool leader_thread) {
    asm volatile("s_waitcnt vmcnt(0)" ::: "memory");
    __syncthreads();
    if (leader_thread) {
        __builtin_amdgcn_s_waitcnt(0);
        unsigned nloc = st[0], nx = st[1];
        if (nloc == 0u) { xcd_barrier_complete(bar, x, nloc, nx); st[0] = nloc; st[1] = nx; }
        const unsigned old = xb_add(&bar[XB_XSUB(x)], 1u);
        const unsigned gen = old / nloc;
        if (old + 1u == (gen + 1u) * nloc) {
            __builtin_amdgcn_fence(__ATOMIC_RELEASE, "agent");
            asm volatile("s_waitcnt vmcnt(0)" ::: "memory");
            const unsigned og = xb_add(&bar[XB_TOP], 1u);
            const unsigned tg = og / nx;
            if (og + 1u == (tg + 1u) * nx) xb_add(&bar[XB_TOPGEN], 1u);
            else XB_SPIN(xb_ld(&bar[XB_TOPGEN]) == tg, bar);
            __builtin_amdgcn_fence(__ATOMIC_ACQUIRE, "agent");
            xb_add(&bar[XB_XGEN(x)], 1u);
            asm volatile("s_waitcnt vmcnt(0)" ::: "memory");
        } else {
            XB_SPIN(xb_ld(&bar[XB_XGEN(x)]) == gen, bar);
            __builtin_amdgcn_fence(__ATOMIC_ACQUIRE, "agent");
            asm volatile("s_waitcnt vmcnt(0)" ::: "memory");
        }
    }
    __syncthreads();
}

__global__ void __launch_bounds__(NTHR, 2) fwd_megakernel(Args a_unused) {
    extern __shared__ __attribute__((aligned(16))) unsigned char lds_raw[];
    cg::grid_group grid = cg::this_grid();
    LAS unsigned char* lds = (LAS unsigned char*)lds_raw;
    LAS unsigned char* xl = lds + XCH_OFF;
    const int G = gridDim.x, NGW = G * NWAVES;
    volatile LAS unsigned* bst = (volatile LAS unsigned*)(lds + LDS_BYTES - 16);
    if (threadIdx.x == 0) { bst[0] = 0u; bst[1] = 0u; (void)xb_add((unsigned*)(a_unused.ws + WS_BAR) + XB_XCNT(xb_xcc_id()), 1u); }
    __syncthreads();
    grid.sync();
    const int wave0 = __builtin_amdgcn_readfirstlane(threadIdx.x >> 6);
    for (int ph = 0; ph < NPHASE; ++ph) {
        ArgsP a = (ArgsP)__builtin_amdgcn_kernarg_segment_ptr(); asm volatile("" : "+s"(a));
        int wv = wave0; asm volatile("" : "+s"(wv));
#define TIDNOW() ([&]() { int t_; asm volatile("v_mbcnt_lo_u32_b32 %0, -1, 0\n\tv_mbcnt_hi_u32_b32 %0, -1, %0" : "=v"(t_)); return t_ + wv * 64; })()
        const int tid = TIDNOW();
        int bid = blockIdx.x; asm volatile("" : "+s"(bid));
        unsigned char* ws = a->ws; asm volatile("" : "+s"(ws)); ASSUME_GLOBAL(ws);
        float* outp = a->out; asm volatile("" : "+s"(outp)); ASSUME_GLOBAL(outp);
        const int lane = tid & 63, wave = __builtin_amdgcn_readfirstlane(tid >> 6), gw = bid * NWAVES + wave;
        float* mods = (float*)(ws + WS_MODS); const float* cs = (const float*)(ws + WS_CS);
        bf16_t* XB = (bf16_t*)(ws + WS_XB); bf16_t* Hb = (bf16_t*)(ws + WS_H); bf16_t* KVb = (bf16_t*)(ws + WS_KV); bf16_t* KRb = (bf16_t*)(ws + WS_KR); unsigned char* ACT = ws + WS_ACT;
        int kind, l; phase_of(ph, kind, l);
        const float* mods_l = mods + (size_t)l * 8 * 6144;
        const int j = l - 2;
        switch (kind) {
        case K_PREP: { const int tid_ = TIDNOW(); prep_phase(a, lds, tid_, tid_ & 63, wave, bid); } break;
        case K_NORM1: if (l == 0) norm_rows(AF(x), AF(norm1_g) + l * DM, mods_l, 0, 1, Hb, nullptr, nullptr, gw, NGW, lane);
                      else norm_rows_b(XB, AF(norm1_g) + l * DM, mods_l, 0, 1, Hb, nullptr, nullptr, gw, NGW, lane);
                      break;
        case K_NORM2: norm_rows_b(XB, AF(norm2_g) + l * DM, mods_l, 3, 4, Hb, nullptr, nullptr, gw, NGW, lane); ffn_weights(a, lds, l, lane, wave, bid); break;
        case K_POOLED: pooled_phase(Hb, (bf16_t*)ACT, bid * NTHR + TIDNOW(), G * NTHR); break;
        case K_NORMA: norm_rows_b(XB, AF(norm1_g) + l * DM, mods_l, 0, 1, (bf16_t*)(ACT + ACT_Q), AF(kv_in_g), (l == 2) ? Hb : nullptr, gw, NGW, lane); break;
        case K_NORMB:
            cq_norm((const bf16_t*)(ACT + ACT_CQRAW), AF(q_norm_g) + j * 384, Hb, gw, NGW, lane);
            if (l == 2) ckv_norm((const bf16_t*)(ACT + ACT_KVRAW), AF(ckv_norm_g), cs, (bf16_t*)(ACT + ACT_CKV), KRb, gw, NGW, lane);
            break;
        case K_GPOOL: case K_GDOWN: case K_GWO: {
            pg8::Gemm g; pg8::EpiRes E; E.out = XB; E.base = XB; E.base_f32 = 0; E.pb = nullptr; E.ps = nullptr;
            if (kind == K_GPOOL) { g = pg8::Gemm{(const bf16_t*)ACT, (const bf16_t*)(ws + WS_WPOOL) + (size_t)l * 4 * 65536, 1024, 256, 256}; if (l == 0) { E.base = AF(x); E.base_f32 = 1; } E.gate = mods_l + 2 * 1024; E.pb = AF(pool_b) + l * DM; E.ps = AF(pool_scale) + l * DM; }
            else if (kind == K_GDOWN) { g = pg8::Gemm{(const bf16_t*)ACT, (const bf16_t*)(ws + WS_WDN), FF, FF, 0}; E.gate = mods_l + 5 * 1024; }
            else { g = pg8::Gemm{(const bf16_t*)(ACT + ACT_O), (const bf16_t*)(ws + WS_WO) + (size_t)j * 1024 * 1024, 1024, 1024, 0}; E.gate = mods_l + 2 * 1024; }
            pg8::Order S; S.init(128, 4, G, bid);
            if (kind == K_GDOWN) {
                const float* cw = AF(conv_w) + (size_t)l * 3 * FF; const float* cb = AF(conv_b) + (size_t)l * FF;
                const float* topa = (const float*)(ws + WS_TOPA); const float* topv = (const float*)(ws + WS_TOPV); const float* bota = (const float*)(ws + WS_BOTA); bf16_t* act = (bf16_t*)ACT;
                for (int i = 0; ; ++i) { pg8::Unit u; if (!S.next(i, u)) break; if ((u.pm & 15) == 0) continue;
                    for (int e = TIDNOW(); e < 2 * FF; e += NTHR) { const int i2 = e >= FF ? 1 : 0, f = e - i2 * FF;
                        const float b0 = bota[(size_t)((u.pm - 1) * 2) * FF + f], b1 = bota[(size_t)((u.pm - 1) * 2 + 1) * FF + f], t0v = topa[(size_t)(u.pm * 2) * FF + f], t1v = topa[(size_t)(u.pm * 2 + 1) * FF + f];
                        const float am2 = i2 ? b1 : b0, am1 = i2 ? t0v : b1, cur = i2 ? t1v : t0v, v = topv[(size_t)(u.pm * 2 + i2) * FF + f];
                        const float ac = cw[f] * am2 + cw[FF + f] * am1 + cw[2 * FF + f] * cur + cb[f];
                        const f32x2 gg = pg8::gelu_pk((f32x2){ac, ac});
                        act[(size_t)(u.pm * 256 + i2) * FF + f] = (bf16_t)f2bf(gg.x * v); } }
                asm volatile("s_waitcnt vmcnt(0)" ::: "memory"); __syncthreads();
            }
            pg8::gemm_phase<pg8::EpiRes, 0>(lds, xl, g, S, E, TIDNOW());
        } break;
        case K_GUP: {
            pg8::Gemm g{Hb, (const bf16_t*)(ws + WS_WUP), 1024, 1024, 0};
            pg8::EpiUp E{(bf16_t*)ACT, AF(conv_w) + (size_t)l * 3 * FF, AF(conv_b) + (size_t)l * FF, (float*)(ws + WS_TOPA), (float*)(ws + WS_TOPV), (float*)(ws + WS_BOTA)};
            pg8::Order S; S.init(128, 22, G, bid);
            pg8::gemm_phase<pg8::EpiUp, 0>(lds, xl, g, S, E, TIDNOW());
        } break;
        case K_GEMMA: case K_GEMMB: {
            if (kind == K_GEMMB) {
                pg8::Gemm g{Hb, (const bf16_t*)(ws + WS_WUQ + j * WUQ_SZ), 384, 384, 0};
                pg8::EpiQ E{(bf16_t*)(ACT + ACT_Q), cs};
                pg8::Order S; S.init(128, 6, G, bid);
                pg8::gemm_phase<pg8::EpiQ, 0>(lds, xl, g, S, E, TIDNOW());
            }
            const int ng = (kind == K_GEMMA) ? (l == 2 ? 2 : 1) : (l == 2 ? 1 : 0);
            for (int i = 0; i < ng; ++i) {
                pg8::Gemm g; pg8::EpiBf16 E; int nN;
                if (kind == K_GEMMA && i == 0) { g = pg8::Gemm{(const bf16_t*)(ACT + ACT_Q), (const bf16_t*)(ws + WS_WDQ) + (size_t)j * 512 * 1024, 1024, 1024, 0}; E = pg8::EpiBf16{(bf16_t*)(ACT + ACT_CQRAW), 512}; nN = 2; }
                else if (kind == K_GEMMA) { g = pg8::Gemm{Hb, (const bf16_t*)(ws + WS_WDKV), 1024, 1024, 0}; E = pg8::EpiBf16{(bf16_t*)(ACT + ACT_KVRAW), 512}; nN = 2; }
                else { g = pg8::Gemm{(const bf16_t*)(ACT + ACT_CKV), (const bf16_t*)(ws + WS_WKV), 256, 256, 0}; E = pg8::EpiBf16{KVb, 2048}; nN = 8; }
                pg8::Order S; S.init(128, nN, G, bid);
                pg8::gemm_phase<pg8::EpiBf16, 0>(lds, xl, g, S, E, TIDNOW());
            }
        } break;
        case K_ATTN: att::attn_phase((char*)lds_raw, (const bf16_t*)(ACT + ACT_Q), KVb, KRb, (bf16_t*)(ACT + ACT_O), TIDNOW(), bid); break;
        case K_FINAL: final_norm(XB, outp, AF(final_g), gw, NGW, lane);
            break;
        }
        if (ph + 1 < NPHASE) xcd_barrier((unsigned*)(ws + WS_BAR), xb_xcc_id(), bst, TIDNOW() == 0);
    }
}

extern "C" void kernel_launch(void* const* d_in, const int* in_sizes, int n_in, void* d_out, int out_size, void* d_ws, size_t ws_size, hipStream_t stream) {
    static int grid = 0;
    if (grid == 0) {
        if (n_in != 24 || out_size != MT * DM || ws_size < WS_END) { fprintf(stderr, "kernel_launch: unexpected shapes (n_in %d out %d ws %zu need %zu)\n", n_in, out_size, ws_size, (size_t)WS_END); grid = -1; return; }
        int dev = 0, cus = 0, per_cu = 0;
        (void)hipGetDevice(&dev);
        if (hipDeviceGetAttribute(&cus, hipDeviceAttributeMultiprocessorCount, dev) != hipSuccess || cus <= 0) cus = 256;
        if (hipFuncSetAttribute((const void*)fwd_megakernel, hipFuncAttributeMaxDynamicSharedMemorySize, LDS_BYTES) != hipSuccess) { fprintf(stderr, "kernel_launch: hipFuncSetAttribute failed\n"); grid = -1; return; }
        if (hipOccupancyMaxActiveBlocksPerMultiprocessor(&per_cu, (const void*)fwd_megakernel, NTHR, LDS_BYTES) != hipSuccess || per_cu < 1) { fprintf(stderr, "kernel_launch: occupancy query gave %d\n", per_cu); per_cu = 1; }
        (void)hipGetLastError();
        grid = cus * per_cu;
    }
    if (grid < 0) return;
    Args a{};
    a.x = (const float*)d_in[0]; a.c = (const float*)d_in[1]; a.pos = (const int*)d_in[2]; a.mod_w = (const float*)d_in[3]; a.mod_b = (const float*)d_in[4];
    a.norm1_g = (const float*)d_in[5]; a.norm2_g = (const float*)d_in[6]; a.pool_w = (const float*)d_in[7]; a.pool_b = (const float*)d_in[8]; a.pool_scale = (const float*)d_in[9];
    a.kv_in_g = (const float*)d_in[10]; a.w_dkv = (const float*)d_in[11]; a.ckv_norm_g = (const float*)d_in[12]; a.w_uk = (const float*)d_in[13]; a.w_uv = (const float*)d_in[14];
    a.w_dq = (const float*)d_in[15]; a.q_norm_g = (const float*)d_in[16]; a.w_uq = (const float*)d_in[17]; a.w_o = (const float*)d_in[18];
    a.w_up = (const float*)d_in[19]; a.conv_w = (const float*)d_in[20]; a.conv_b = (const float*)d_in[21]; a.w_down = (const float*)d_in[22]; a.final_g = (const float*)d_in[23];
    a.out = (float*)d_out; a.ws = (unsigned char*)d_ws;
    if (hipMemsetAsync((char*)d_ws + WS_BAR, 0, 16384, stream) != hipSuccess) { fprintf(stderr, "kernel_launch: hipMemsetAsync failed\n"); return; }
    void* args[] = {&a};
    hipError_t e = hipLaunchCooperativeKernel((const void*)fwd_megakernel, dim3(grid), dim3(NTHR), args, LDS_BYTES, stream);
    if (e != hipSuccess) fprintf(stderr, "kernel_launch: cooperative launch failed: %s (grid %d)\n", hipGetErrorString(e), grid);
}
```

```cpp
#include <hip/hip_runtime.h>
#include <hip/hip_cooperative_groups.h>
#include <cstdio>
#include <cstdint>
namespace cg = cooperative_groups;

#define LAS __attribute__((address_space(3)))
typedef unsigned short bf16_t;
typedef short bf16x8 __attribute__((ext_vector_type(8)));
typedef short s16x4 __attribute__((ext_vector_type(4)));
typedef float f32x2 __attribute__((ext_vector_type(2)));
typedef float f32x4 __attribute__((ext_vector_type(4)));
typedef float f32x16 __attribute__((ext_vector_type(16)));
typedef unsigned u32x2 __attribute__((ext_vector_type(2)));
typedef unsigned u32x4 __attribute__((ext_vector_type(4)));

constexpr int NB = 8, SEQ = 4096, DM = 1024, MT = NB * SEQ, FF = 2816, NH = 8;
constexpr int NWAVES = 8, NTHR = 512;
constexpr float EPS = 1e-6f;
constexpr size_t MiB = 1u << 20;
constexpr size_t WS_MODS = 0;
constexpr size_t WS_CS = 1 * MiB;
constexpr size_t WS_WUP = 16 * MiB;
constexpr size_t WUP_SZ = (size_t)5632 * 1024 * 2;
constexpr size_t WS_WDN = WS_WUP + WUP_SZ;
constexpr size_t WDN_SZ = (size_t)1024 * 2816 * 2;
constexpr size_t WS_WPOOL = WS_WDN + WDN_SZ;
constexpr size_t WS_WDKV = WS_WPOOL + 1 * MiB;
constexpr size_t WS_WKV = WS_WDKV + 1 * MiB;
constexpr size_t WS_WDQ = WS_WKV + 1 * MiB;
constexpr size_t WS_WUQ = WS_WDQ + 2 * MiB;
constexpr size_t WUQ_SZ = (size_t)1536 * 384 * 2;
constexpr size_t WS_WO = WS_WUQ + 2 * WUQ_SZ + 0;
constexpr size_t WS_WEND = WS_WO + 4 * MiB;
static_assert(WS_WEND <= 45 * MiB, "weights region");
constexpr size_t WS_TOPA = 45 * MiB, WS_TOPV = 48 * MiB, WS_BOTA = 51 * MiB;
constexpr size_t WS_H = 54 * MiB + 4096;
constexpr size_t WS_XB = 119 * MiB;
constexpr size_t WS_KV = 183 * MiB;
constexpr size_t WS_KR = 311 * MiB;
constexpr size_t WS_ACT = 315 * MiB;
constexpr size_t WS_END = 491 * MiB;
constexpr size_t ACT_Q = 0, ACT_O = 96 * MiB, ACT_CQRAW = 96 * MiB, ACT_KVRAW = 128 * MiB, ACT_CKV = 160 * MiB;

constexpr int RING_BYTES = 131072, XCH_OFF = RING_BYTES, LDS_BYTES = 155648;

struct Args {
    const float* x; const float* c; const int* pos; const float* mod_w; const float* mod_b; const float* norm1_g; const float* norm2_g;
    const float* pool_w; const float* pool_b; const float* pool_scale; const float* kv_in_g; const float* w_dkv; const float* ckv_norm_g;
    const float* w_uk; const float* w_uv; const float* w_dq; const float* q_norm_g; const float* w_uq; const float* w_o;
    const float* w_up; const float* conv_w; const float* conv_b; const float* w_down; const float* final_g;
    float* out; unsigned char* ws;
};

typedef const __attribute__((address_space(4))) Args* ArgsP;
#define GAS __attribute__((address_space(1)))
#if defined(__HIP_DEVICE_COMPILE__)
#define ASSUME_GLOBAL(p) __builtin_assume(!__builtin_amdgcn_is_shared((const __attribute__((address_space(0))) void*)(p)) && !__builtin_amdgcn_is_private((const __attribute__((address_space(0))) void*)(p)))
#else
#define ASSUME_GLOBAL(p) ((void)0)
#endif
#define AF(name) ([&]() { const float* p_ = a->name; ASSUME_GLOBAL(p_); return p_; })()
#define AI(name) ([&]() { const int* p_ = a->name; ASSUME_GLOBAL(p_); return p_; })()

__device__ __forceinline__ unsigned f2bf(float f) { unsigned u = __builtin_bit_cast(unsigned, f); return (u + 0x7fffu + ((u >> 16) & 1u)) >> 16; }
__device__ __forceinline__ unsigned pk2(float lo, float hi) { return f2bf(lo) | (f2bf(hi) << 16); }
__device__ __forceinline__ unsigned cvt_pk_bf16(float lo, float hi) { unsigned r; asm volatile("v_cvt_pk_bf16_f32 %0, %1, %2" : "=v"(r) : "v"(lo), "v"(hi)); return r; }
__device__ __forceinline__ float bflo(unsigned u) { return __builtin_bit_cast(float, u << 16); }
__device__ __forceinline__ float bfhi(unsigned u) { return __builtin_bit_cast(float, u & 0xffff0000u); }
__device__ __forceinline__ void swap16_self(unsigned x, unsigned& r0, unsigned& r1) { unsigned y = x; asm("" : "+v"(y)); auto r = __builtin_amdgcn_permlane16_swap(x, y, false, false); r0 = r[0]; r1 = r[1]; }
__device__ __forceinline__ void swap32_self(unsigned x, unsigned& r0, unsigned& r1) { unsigned y = x; asm("" : "+v"(y)); auto r = __builtin_amdgcn_permlane32_swap(x, y, false, false); r0 = r[0]; r1 = r[1]; }
#define DPPF(v, ctrl) __builtin_bit_cast(float, __builtin_amdgcn_update_dpp(0, __builtin_bit_cast(int, (v)), (ctrl), 0xf, 0xf, false))
__device__ __forceinline__ float wave_sum(float v) {
    v += DPPF(v, 0xB1); v += DPPF(v, 0x4E); v += DPPF(v, 0x141); v += DPPF(v, 0x140);
    unsigned a, b;
    swap16_self(__builtin_bit_cast(unsigned, v), a, b); v = __builtin_bit_cast(float, a) + __builtin_bit_cast(float, b);
    swap32_self(__builtin_bit_cast(unsigned, v), a, b); v = __builtin_bit_cast(float, a) + __builtin_bit_cast(float, b);
    return v;
}
#define LDS_WAIT() asm volatile("s_waitcnt lgkmcnt(0)" ::: "memory")

namespace pg8 {
constexpr int BM = 256, BK = 64, HALF = 128, HTB = HALF * BK * 2, NXCD = 8, WGM = 8;
__device__ __forceinline__ int lds_byte(int r, int c) { const int st = (r >> 4) * 2 + (c >> 5), rr = r & 15, cc = c & 31, ob = rr * 64 + cc * 2; return st * 1024 + (ob ^ (((ob >> 9) & 1) << 5)); }
__device__ __forceinline__ void stage_rc(int b, int& R, int& C) { const int st = b / 1024, sb = b % 1024, swz = sb ^ (((sb >> 9) & 1) << 5); R = (st >> 1) * 16 + swz / 64; C = (st & 1) * 32 + (swz % 64) / 2; }
__device__ __forceinline__ int perm32(int rho) { const int n = rho >> 4, i = rho & 15; return 8 * (i >> 2) + 4 * n + (i & 3); }
struct Unit { int pm, pn; };
struct Order {
    int nM, nN, nwg, G, c;
    __device__ void init(int nM_, int nN_, int G_, int c_) { nM = nM_; nN = nN_; nwg = nM * nN; G = G_; c = c_; }
    __device__ bool next(int i, Unit& u) const {
        const long L = (long)i * G + c; if (L >= nwg) return false;
        int wgid = (int)L; { const int q = nwg / NXCD, r = nwg % NXCD, xcd = wgid % NXCD, off = wgid / NXCD; wgid = (xcd < r ? xcd * (q + 1) : r * (q + 1) + (xcd - r) * q) + off; }
        const int nig = WGM * nN, gid = wgid / nig, fm = gid * WGM, gsz = (nM - fm) < WGM ? (nM - fm) : WGM;
        u.pm = fm + ((wgid % nig) % gsz); u.pn = (wgid % nig) / gsz; return true;
    }
};
struct Gemm { const bf16_t* A; const bf16_t* Bt; int lda; int K; int acs; };
template <int MODE> __device__ __forceinline__ ptrdiff_t a_off(const Gemm& g, const Unit& u) {
    if (MODE == 2) { const int b = u.pm / 17, j = u.pm - b * 17; return ((ptrdiff_t)(b * 4096 + j * 254 - 2) * g.lda) * 2; }
    return ((ptrdiff_t)u.pm * 256 * g.lda + (ptrdiff_t)u.pn * g.acs) * 2;
}

__device__ __forceinline__ f32x2 gelu_pk(f32x2 v) {
    const f32x2 z = __builtin_elementwise_min(__builtin_elementwise_max(v, (f32x2){-4.3f, -4.3f}), (f32x2){4.3f, 4.3f}) * 0.232558139534883721f, u = z * z;
    f32x2 q = u * 2.9056504693371608f + (-15.464755185649892f);
    q = q * u + 36.337021862829715f; q = q * u + (-50.1697976120365f); q = q * u + 45.89880639920095f; q = q * u + (-29.836445535451812f);
    q = q * u + 14.38621083521653f; q = q * u + (-5.271915130776272f); q = q * u + 1.7152232528538645f;
    return v * (z * q + 0.5f);
}

struct EpiRes {
    static constexpr bool PERM = true;
    const void* base; int base_f32; bf16_t* out; const float* gate; const float* pb; const float* ps;
    __device__ __forceinline__ void operator()(const f32x4 (&acc)[2][2][4][2], const Unit& u, int wr, int wc, int fr, int fq, LAS unsigned char*, int) const {
        const int b = u.pm >> 4, row0 = u.pm * BM + wr * 64 + fr, col0 = u.pn * BM + wc * 32 + 8 * fq;
        f32x4 mul[2][2], add[2][2];
#pragma unroll
        for (int bj = 0; bj < 2; ++bj)
#pragma unroll
            for (int n = 0; n < 2; ++n) { const int col = col0 + bj * HALF + n * 4; const f32x4 g = *(const GAS f32x4*)(gate + b * 6144 + col);
                if (pb) { const f32x4 s = *(const GAS f32x4*)(ps + col), bb = *(const GAS f32x4*)(pb + col); mul[bj][n] = g * s; add[bj][n] = mul[bj][n] * bb; }
                else { mul[bj][n] = g; add[bj][n] = (f32x4){0.f, 0.f, 0.f, 0.f}; } }
#pragma unroll
        for (int ai = 0; ai < 2; ++ai)
#pragma unroll
            for (int m = 0; m < 4; ++m) { const size_t off = (size_t)(row0 + ai * HALF + m * 16) * DM + col0;
#pragma unroll
                for (int bj = 0; bj < 2; ++bj) { f32x4 b0, b1;
                    if (base_f32) { b0 = *(const GAS f32x4*)((const float*)base + off + bj * HALF); b1 = *(const GAS f32x4*)((const float*)base + off + bj * HALF + 4); }
                    else { const u32x4 w = *(const GAS u32x4*)((const bf16_t*)base + off + bj * HALF); b0 = (f32x4){bflo(w.x), bfhi(w.x), bflo(w.y), bfhi(w.y)}; b1 = (f32x4){bflo(w.z), bfhi(w.z), bflo(w.w), bfhi(w.w)}; }
                    const f32x4 v0 = b0 + acc[ai][bj][m][0] * mul[bj][0] + add[bj][0], v1 = b1 + acc[ai][bj][m][1] * mul[bj][1] + add[bj][1];
                    u32x4 o; o.x = cvt_pk_bf16(v0[0], v0[1]); o.y = cvt_pk_bf16(v0[2], v0[3]); o.z = cvt_pk_bf16(v1[0], v1[1]); o.w = cvt_pk_bf16(v1[2], v1[3]);
                    *(GAS u32x4*)(out + off + bj * HALF) = o; } }
    }
};
struct EpiBf16 {
    static constexpr bool PERM = true;
    bf16_t* O; int ldc;
    __device__ __forceinline__ void operator()(const f32x4 (&acc)[2][2][4][2], const Unit& u, int wr, int wc, int fr, int fq, LAS unsigned char*, int) const {
        const int row0 = u.pm * BM + wr * 64 + fr, col0 = u.pn * BM + wc * 32 + 8 * fq;
#pragma unroll
        for (int ai = 0; ai < 2; ++ai)
#pragma unroll
            for (int m = 0; m < 4; ++m) { bf16_t* rowp = O + (size_t)(row0 + ai * HALF + m * 16) * ldc + col0;
#pragma unroll
                for (int bj = 0; bj < 2; ++bj) { const f32x4 v0 = acc[ai][bj][m][0], v1 = acc[ai][bj][m][1];
                    u32x4 w; w.x = cvt_pk_bf16(v0[0], v0[1]); w.y = cvt_pk_bf16(v0[2], v0[3]); w.z = cvt_pk_bf16(v1[0], v1[1]); w.w = cvt_pk_bf16(v1[2], v1[3]);
                    *(GAS u32x4*)(rowp + bj * HALF) = w; } }
    }
};
struct EpiQ {
    static constexpr bool PERM = true;
    bf16_t* O; const float* cs;
    __device__ __forceinline__ void operator()(const f32x4 (&acc)[2][2][4][2], const Unit& u, int wr, int wc, int fr, int fq, LAS unsigned char*, int) const {
        const int row0 = u.pm * BM + wr * 64 + fr;
#pragma unroll
        for (int bj = 0; bj < 2; ++bj) { const int c0 = u.pn * BM + bj * HALF + wc * 32 + 8 * fq, hc = c0 % 192; const bool rope = hc >= 128; const int i0 = (hc - 128) >> 1;
#pragma unroll
            for (int ai = 0; ai < 2; ++ai)
#pragma unroll
                for (int m = 0; m < 4; ++m) { const int row = row0 + ai * HALF + m * 16; f32x4 v0 = acc[ai][bj][m][0], v1 = acc[ai][bj][m][1];
                    if (rope) { const f32x4 ca = *(const GAS f32x4*)(cs + (size_t)row * 64 + i0 * 2), cb = *(const GAS f32x4*)(cs + (size_t)row * 64 + i0 * 2 + 4);
                        f32x4 r0, r1;
                        r0[0] = v0[0] * ca[0] - v0[1] * ca[1]; r0[1] = v0[1] * ca[0] + v0[0] * ca[1]; r0[2] = v0[2] * ca[2] - v0[3] * ca[3]; r0[3] = v0[3] * ca[2] + v0[2] * ca[3];
                        r1[0] = v1[0] * cb[0] - v1[1] * cb[1]; r1[1] = v1[1] * cb[0] + v1[0] * cb[1]; r1[2] = v1[2] * cb[2] - v1[3] * cb[3]; r1[3] = v1[3] * cb[2] + v1[2] * cb[3];
                        v0 = r0; v1 = r1; }
                    u32x4 w; w.x = cvt_pk_bf16(v0[0], v0[1]); w.y = cvt_pk_bf16(v0[2], v0[3]); w.z = cvt_pk_bf16(v1[0], v1[1]); w.w = cvt_pk_bf16(v1[2], v1[3]);
                    *(GAS u32x4*)(O + (size_t)row * 1536 + c0) = w; } }
    }
};
__device__ __forceinline__ float dpp_prev1(float cur, float prev) {
    const int o = __builtin_amdgcn_mov_dpp(__builtin_bit_cast(int, prev), 0x121, 0xf, 0xf, true);
    return __builtin_bit_cast(float, __builtin_amdgcn_update_dpp(o, __builtin_bit_cast(int, cur), 0x111, 0xf, 0xf, false));
}
__device__ __forceinline__ float dpp_prev2(float cur, float prev) {
    const int o = __builtin_amdgcn_mov_dpp(__builtin_bit_cast(int, prev), 0x122, 0xf, 0xf, true);
    return __builtin_bit_cast(float, __builtin_amdgcn_update_dpp(o, __builtin_bit_cast(int, cur), 0x112, 0xf, 0xf, false));
}
struct EpiUp {
    static constexpr bool PERM = true;
    bf16_t* act; const float* cw; const float* cb; float* topa; float* topv; float* bota;
    __device__ __forceinline__ void operator()(const f32x4 (&acc)[2][2][4][2], const Unit& u, int wr, int wc, int fr, int fq, LAS unsigned char* xl, int) const {
        const int jt = u.pm & 15, t0 = jt * 256;
        const int f0 = u.pn * 128 + wc * 32 + 8 * fq;
        if (fr >= 14) {
#pragma unroll
            for (int ai = 0; ai < 2; ++ai) { LAS f32x4* p = (LAS f32x4*)(xl + ((ai * 2 + wr) * 4 + wc) * 256 + ((fr & 1) * 4 + fq) * 32); p[0] = acc[ai][0][3][0]; p[1] = acc[ai][0][3][1]; }
        }
        LDS_WAIT(); __builtin_amdgcn_s_barrier(); asm volatile("" ::: "memory");
        f32x4 halo[2][2];
#pragma unroll
        for (int ai = 0; ai < 2; ++ai) {
            const int sa = wr ? ai : 0, sw = wr ? 0 : 1;
            const LAS f32x4* p = (const LAS f32x4*)(xl + ((sa * 2 + sw) * 4 + wc) * 256 + ((fr & 1) * 4 + fq) * 32);
            halo[ai][0] = p[0]; halo[ai][1] = p[1];
        }
        f32x4 w0[2], w1[2], w2[2], bb[2];
#pragma unroll
        for (int n = 0; n < 2; ++n) { w0[n] = *(const GAS f32x4*)(cw + f0 + 4 * n); w1[n] = *(const GAS f32x4*)(cw + FF + f0 + 4 * n); w2[n] = *(const GAS f32x4*)(cw + 2 * FF + f0 + 4 * n); bb[n] = *(const GAS f32x4*)(cb + f0 + 4 * n); }
        LDS_WAIT();
#pragma unroll
        for (int ai = 0; ai < 2; ++ai)
#pragma unroll
            for (int m = 0; m < 4; ++m) {
                const int r = ai * HALF + wr * 64 + m * 16 + fr, t = t0 + r;
                f32x4 o[2];
#pragma unroll
                for (int n = 0; n < 2; ++n) {
                    const f32x4 c = acc[ai][0][m][n]; const f32x4 p = (m > 0) ? acc[ai][0][m > 0 ? m - 1 : 0][n] : halo[ai][n];
                    f32x4 x1, x2;
#pragma unroll
                    for (int j = 0; j < 4; ++j) { x1[j] = dpp_prev1(c[j], p[j]); x2[j] = dpp_prev2(c[j], p[j]); }
                    if (ai == 0 && m == 0) { if (t0 == 0 && wr == 0) {
                        if (t < 1) x1 = (f32x4){0.f, 0.f, 0.f, 0.f};
                        if (t < 2) x2 = (f32x4){0.f, 0.f, 0.f, 0.f}; } }
                    const f32x4 a = __builtin_elementwise_fma(x2, w0[n], __builtin_elementwise_fma(x1, w1[n], __builtin_elementwise_fma(c, w2[n], bb[n])));
                    const f32x2 g0 = gelu_pk((f32x2){a[0], a[1]}), g1 = gelu_pk((f32x2){a[2], a[3]});
                    const f32x4 v = acc[ai][1][m][n];
                    const f32x2 r0 = g0 * (f32x2){v[0], v[1]}, r1 = g1 * (f32x2){v[2], v[3]};
                    o[n] = (f32x4){r0.x, r0.y, r1.x, r1.y};
                }
                u32x4 w; w.x = cvt_pk_bf16(o[0][0], o[0][1]); w.y = cvt_pk_bf16(o[0][2], o[0][3]); w.z = cvt_pk_bf16(o[1][0], o[1][1]); w.w = cvt_pk_bf16(o[1][2], o[1][3]);
                const bool deferred = (ai == 0 && m == 0) && (wr == 0 && jt > 0 && fr < 2);
                if (!deferred) *(GAS u32x4*)(act + (size_t)(u.pm * BM + r) * FF + f0) = w;
                if (ai == 0 && m == 0) { if (wr == 0 && jt > 0 && fr < 2) { float* pa = topa + (size_t)(u.pm * 2 + fr) * FF + f0; float* pv = topv + (size_t)(u.pm * 2 + fr) * FF + f0;
                        *(GAS f32x4*)pa = acc[0][0][0][0]; *(GAS f32x4*)(pa + 4) = acc[0][0][0][1]; *(GAS f32x4*)pv = acc[0][1][0][0]; *(GAS f32x4*)(pv + 4) = acc[0][1][0][1]; } }
                if (ai == 1 && m == 3) { if (wr == 1 && fr >= 14) { float* pb = bota + (size_t)(u.pm * 2 + (fr - 14)) * FF + f0; *(GAS f32x4*)pb = acc[1][0][3][0]; *(GAS f32x4*)(pb + 4) = acc[1][0][3][1]; } }
            }
    }
};

template <class Epi, int MODE>
__device__ __forceinline__ void gemm_phase(LAS unsigned char* lds, LAS unsigned char* xl, const Gemm g, const Order& S, const Epi& E, const int tid) {
    const int wid = __builtin_amdgcn_readfirstlane(tid >> 6), lane = tid & 63, wr = wid >> 2, wc = wid & 3, fr = lane & 15, fq = lane >> 4;
    const int K = g.K, nt = K / BK, lda = g.lda;
    unsigned voffA[2], voffB[2];
#pragma unroll
    for (int i = 0; i < 2; ++i) { int R, C; stage_rc(tid * 16 + i * 8192, R, C); const int Rb = Epi::PERM ? ((R & ~31) + perm32(R & 31)) : R;
        voffA[i] = (unsigned)(R * lda + C) * 2u; voffB[i] = (unsigned)(Rb * K + C) * 2u; }
    const size_t kstep = (size_t)(BK * 2);
    const size_t hstepA = (size_t)HALF * lda * 2, hstepB = (size_t)HALF * K * 2;
    const size_t tstepB = 2 * hstepB;
    const unsigned ldsw = (unsigned)wid * 1024u, ldsbase = (unsigned)(uintptr_t)lds;
    const int aoff = lds_byte(wr * 64 + fr, fq * 8), boff = lds_byte(wc * 32 + fr, fq * 8);
#define PG8_SA(b, h) (((b) * 2 + (h)) * HTB)
#define PG8_SB(b, h) ((4 + (b) * 2 + (h)) * HTB)
#define PG8_STAGE(bufoff, gbase, voff) do { _Pragma("unroll") for (int _i = 0; _i < 2; ++_i) { unsigned _keep; \
        asm volatile("s_mov_b32 %0, m0\n\ts_mov_b32 m0, %3\n\ts_nop 0\n\tglobal_load_lds_dwordx4 %1, %2\n\ts_mov_b32 m0, %0" : "=&s"(_keep) : "v"((voff)[_i]), "s"((const char*)(gbase)), "s"(ldsbase + (unsigned)(bufoff) + ldsw + (unsigned)(_i * 8192)) : "memory"); } } while (0)
#define PG8_LDA(dst, b, h) do { _Pragma("unroll") for (int m = 0; m < 4; ++m) _Pragma("unroll") for (int k = 0; k < 2; ++k) dst[m][k] = *(const LAS bf16x8*)(lds + PG8_SA(b, h) + aoff + m * 2048 + k * 1024); } while (0)
#define PG8_LDB(dst, b, h) do { _Pragma("unroll") for (int n = 0; n < 2; ++n) _Pragma("unroll") for (int k = 0; k < 2; ++k) dst[n][k] = *(const LAS bf16x8*)(lds + PG8_SB(b, h) + boff + n * 2048 + k * 1024); } while (0)
#define PG8_MMA(ai, bj, At, Bt) do { __builtin_amdgcn_s_setprio(1); _Pragma("unroll") for (int m = 0; m < 4; ++m) _Pragma("unroll") for (int n = 0; n < 2; ++n) _Pragma("unroll") for (int k = 0; k < 2; ++k) \
        acc[ai][bj][m][n] = __builtin_amdgcn_mfma_f32_16x16x32_bf16(Bt[n][k], At[m][k], acc[ai][bj][m][n], 0, 0, 0); __builtin_amdgcn_s_setprio(0); } while (0)
#define PG8_WAIT_V(n) asm volatile("s_waitcnt vmcnt(" #n ")" ::: "memory")
#define PG8_WAIT_L(n) asm volatile("s_waitcnt lgkmcnt(" #n ")" ::: "memory")
#define PG8_BAR __builtin_amdgcn_s_barrier()
#define PG8_SCHED __builtin_amdgcn_sched_barrier(0)
    Unit cur, nxt; int ui = 0;
    if (!S.next(0, cur)) return;
    f32x4 acc[2][2][4][2];
#pragma unroll
    for (int a = 0; a < 2; ++a)
#pragma unroll
        for (int b = 0; b < 2; ++b)
#pragma unroll
            for (int m = 0; m < 4; ++m)
#pragma unroll
                for (int n = 0; n < 2; ++n) acc[a][b][m][n] = (f32x4){0.f, 0.f, 0.f, 0.f};
    bf16x8 At[4][2], B0[2][2], B1[2][2];
    const char* cA = (const char*)g.A + a_off<MODE>(g, cur); const char* cB = (const char*)g.Bt + (size_t)cur.pn * tstepB;
    PG8_STAGE(PG8_SB(0, 0), cB, voffB); PG8_STAGE(PG8_SB(0, 1), cB + hstepB, voffB); PG8_STAGE(PG8_SA(0, 0), cA, voffA); PG8_STAGE(PG8_SA(0, 1), cA + hstepA, voffA);
    if (wr == 1) PG8_BAR;
    PG8_WAIT_V(2); PG8_BAR;
    PG8_STAGE(PG8_SB(1, 0), cB + kstep, voffB); PG8_STAGE(PG8_SA(1, 0), cA + kstep, voffA); PG8_STAGE(PG8_SB(1, 1), cB + hstepB + kstep, voffB);
    PG8_WAIT_V(6); PG8_BAR;
    for (;;) {
        const bool has_next = S.next(ui + 1, nxt);
        const char* nA = has_next ? (const char*)g.A + a_off<MODE>(g, nxt) : cA; const char* nB = has_next ? (const char*)g.Bt + (size_t)nxt.pn * tstepB : cB;
        for (int t = 0; t < nt; t += 2) {
            const bool last = (t == nt - 2);
            const char* a1 = cA + (size_t)(t + 1) * kstep;
            const char* a2 = last ? nA : cA + (size_t)(t + 2) * kstep; const char* b2 = last ? nB : cB + (size_t)(t + 2) * kstep;
            const char* a3 = a2 + kstep; const char* b3 = b2 + kstep;
            PG8_LDB(B0, 0, 0); PG8_LDB(B1, 0, 1); PG8_SCHED; PG8_LDA(At, 0, 0); PG8_STAGE(PG8_SA(1, 1), a1 + hstepA, voffA);
            PG8_WAIT_V(8); PG8_WAIT_L(0); PG8_BAR; PG8_MMA(0, 0, At, B0); PG8_MMA(0, 1, At, B1); PG8_BAR; PG8_SCHED;
            PG8_LDA(At, 0, 1); PG8_STAGE(PG8_SB(0, 0), b2, voffB); PG8_STAGE(PG8_SB(0, 1), b2 + hstepB, voffB); PG8_STAGE(PG8_SA(0, 0), a2, voffA);
            PG8_WAIT_V(8); PG8_WAIT_L(0); PG8_BAR; PG8_MMA(1, 0, At, B0); PG8_MMA(1, 1, At, B1); PG8_BAR; PG8_SCHED;
            PG8_LDB(B0, 1, 0); PG8_LDB(B1, 1, 1); PG8_SCHED; PG8_LDA(At, 1, 0); PG8_STAGE(PG8_SA(0, 1), a2 + hstepA, voffA);
            PG8_WAIT_V(8); PG8_WAIT_L(0); PG8_BAR; PG8_MMA(0, 0, At, B0); PG8_MMA(0, 1, At, B1); PG8_BAR; PG8_SCHED;
            PG8_LDA(At, 1, 1); PG8_STAGE(PG8_SB(1, 0), b3, voffB); PG8_STAGE(PG8_SB(1, 1), b3 + hstepB, voffB); PG8_STAGE(PG8_SA(1, 0), a3, voffA);
            PG8_WAIT_V(8); PG8_WAIT_L(0); PG8_BAR; PG8_MMA(1, 0, At, B0); PG8_MMA(1, 1, At, B1); PG8_BAR; PG8_SCHED;
        }
        if (wr == 0) PG8_BAR;
        { int l2; asm volatile("v_mbcnt_lo_u32_b32 %0, -1, 0\n\tv_mbcnt_hi_u32_b32 %0, -1, %0" : "=v"(l2));
          E(acc, cur, wr, wc, l2 & 15, l2 >> 4, xl, l2); }
        if (!has_next) break;
#pragma unroll
        for (int a = 0; a < 2; ++a)
#pragma unroll
            for (int b = 0; b < 2; ++b)
#pragma unroll
                for (int m = 0; m < 4; ++m)
#pragma unroll
                    for (int n = 0; n < 2; ++n) acc[a][b][m][n] = (f32x4){0.f, 0.f, 0.f, 0.f};
        cur = nxt; cA = nA; cB = nB; ++ui;
        if (wr == 1) PG8_BAR;
    }
    PG8_WAIT_V(0);
    PG8_BAR;
#undef PG8_SA
#undef PG8_SB
#undef PG8_STAGE
#undef PG8_LDA
#undef PG8_LDB
#undef PG8_MMA
#undef PG8_WAIT_V
#undef PG8_WAIT_L
#undef PG8_BAR
#undef PG8_SCHED
}
}

namespace att {
constexpr int NW = 8, QBLK = 32, KVBLK = 64, QB = 256;
constexpr int QP = 1536, KP = 2048, KRP = 64, VP = 2048, OP = 1024;
constexpr int KROWB = 272, KRROWB = 144;
constexpr int SHM_V = 16384, SHM_K = 64 * KROWB, SHM_KR = 64 * KRROWB;
constexpr int OFF_V = 0, OFF_K = 2 * SHM_V, OFF_KR = OFF_K + 2 * SHM_K, OFF_WS = OFF_KR + 2 * SHM_KR, OFF_QR = OFF_WS + NW * 256, NQREG = 8, NQLDS = 12 - NQREG, ATT_LDS = OFF_QR + NW * NQLDS * 1024;
static_assert(ATT_LDS <= LDS_BYTES, "attention LDS");
constexpr float SCALE = 0.07216878364870323f;
constexpr float THR = 8.f;
#define KSWZ(row, colB) ((row) * KROWB + (colB))
#define KRSWZ(row, colB) ((row) * KRROWB + (colB))
#define SBAR() __builtin_amdgcn_sched_barrier(0)
__device__ __forceinline__ int v_st(int k, int c) { const int kk = (k & ~0xC) | ((k & 4) << 1) | ((k & 8) >> 1); return ((kk >> 3) * 4 + (c >> 5)) * 512 + ((kk & 7) * 32 + (c & 31)) * 2; }
__device__ __forceinline__ int v_rd_base(int lane) { return ((lane & 3) << 3) | (((lane >> 2) & 3) << 6) | (((lane >> 4) & 1) << 5) | (((lane >> 5) & 1) << 8); }
constexpr int v_rd_off(int d0, int ks, int half) { return d0 * 512 + ks * 4096 + half * 2048; }
__device__ __forceinline__ int crow(int r, int hi) { return (r & 3) + 8 * (r >> 2) + 4 * hi; }
__device__ __forceinline__ bf16x8 ld8(const bf16_t* p) { return *reinterpret_cast<const bf16x8*>(p); }
__device__ __forceinline__ void mask_tile(f32x16& p0, f32x16& p1, int dq) {
    const float NEG = -__builtin_inff();
#pragma unroll
    for (int r = 0; r < 16; ++r) {
        const int c = (r & 3) + 8 * (r >> 2);
        if (dq - c < 0) p0[r] = NEG;
        if (dq - c - 32 < 0) p1[r] = NEG;
    }
}
__device__ __forceinline__ void partialSM(f32x16& p0, f32x16& p1, float& m_reg, float& mn, float& alpha) {
    float pmax = p0[0];
#pragma unroll
    for (int r = 1; r < 16; ++r) pmax = fmaxf(pmax, p0[r]);
#pragma unroll
    for (int r = 0; r < 16; ++r) pmax = fmaxf(pmax, p1[r]);
    { unsigned r0, r1; swap32_self(__float_as_uint(pmax), r0, r1); pmax = fmaxf(__uint_as_float(r0), __uint_as_float(r1)); }
    constexpr float C2 = 1.4426950408889634f * SCALE;
    if (__builtin_expect(__all((pmax - m_reg) * SCALE <= THR), 1)) { mn = m_reg; alpha = 1.f; }
    else { mn = fmaxf(m_reg, pmax); alpha = __builtin_amdgcn_exp2f((m_reg - mn) * C2); m_reg = mn; }
    const float mnL = -mn * C2;
#pragma unroll
    for (int r = 0; r < 16; ++r) p0[r] = fmaf(p0[r], C2, mnL);
#pragma unroll
    for (int r = 0; r < 16; ++r) p1[r] = fmaf(p1[r], C2, mnL);
#pragma unroll
    for (int r = 0; r < 16; ++r) p0[r] = __builtin_amdgcn_exp2f(p0[r]);
}
__device__ __forceinline__ void finishSM(f32x16& p0, f32x16& p1, float alpha, float& l_reg, bf16x8& pa0, bf16x8& pa1, bf16x8& pa2, bf16x8& pa3) {
#pragma unroll
    for (int r = 0; r < 16; ++r) p1[r] = __builtin_amdgcn_exp2f(p1[r]);
    float ps = 0;
#pragma unroll
    for (int r = 0; r < 16; ++r) ps += p0[r];
#pragma unroll
    for (int r = 0; r < 16; ++r) ps += p1[r];
    { unsigned r0, r1; swap32_self(__float_as_uint(ps), r0, r1); ps = __uint_as_float(r0) + __uint_as_float(r1); }
    l_reg = l_reg * alpha + ps;
#define PK4(P, B_, OUT) do { unsigned a0 = cvt_pk_bf16(P[B_+0], P[B_+1]), a1 = cvt_pk_bf16(P[B_+2], P[B_+3]);                          \
        unsigned b0 = cvt_pk_bf16(P[B_+4], P[B_+5]), b1 = cvt_pk_bf16(P[B_+6], P[B_+7]);                                             \
        auto r0 = __builtin_amdgcn_permlane32_swap(a0, b0, false, false); auto r1 = __builtin_amdgcn_permlane32_swap(a1, b1, false, false); \
        u32x4 w = {r0[0], r1[0], r0[1], r1[1]}; OUT = *reinterpret_cast<bf16x8*>(&w); } while (0)
    PK4(p0, 0, pa0); PK4(p0, 8, pa1); PK4(p1, 0, pa2); PK4(p1, 8, pa3);
#undef PK4
}
template <int KB>
__device__ __forceinline__ void qkt(f32x16& p0, f32x16& p1, const char* lds, int r32, int hi, const bf16x8* qr, const LAS char* qrl) {
    p0 = f32x16{}; p1 = f32x16{};
    const char* kb = lds + OFF_K + KB * SHM_K + KSWZ(r32, hi * 16); const char* kr = lds + OFF_KR + KB * SHM_KR + KRSWZ(r32, hi * 16);
#pragma unroll
    for (int d0 = 0; d0 < NQREG; ++d0) {
        bf16x8 b0 = *reinterpret_cast<const bf16x8*>(kb + d0 * 32);
        bf16x8 b1 = *reinterpret_cast<const bf16x8*>(kb + d0 * 32 + 32 * KROWB);
        p0 = __builtin_amdgcn_mfma_f32_32x32x16_bf16(b0, qr[d0], p0, 0, 0, 0);
        p1 = __builtin_amdgcn_mfma_f32_32x32x16_bf16(b1, qr[d0], p1, 0, 0, 0); }
#pragma unroll
    for (int d0 = NQREG; d0 < 8; ++d0) {
        bf16x8 b0 = *reinterpret_cast<const bf16x8*>(kb + d0 * 32);
        bf16x8 b1 = *reinterpret_cast<const bf16x8*>(kb + d0 * 32 + 32 * KROWB);
        const bf16x8 qf = *(const volatile LAS bf16x8*)(qrl + (d0 - NQREG) * 1024);
        p0 = __builtin_amdgcn_mfma_f32_32x32x16_bf16(b0, qf, p0, 0, 0, 0);
        p1 = __builtin_amdgcn_mfma_f32_32x32x16_bf16(b1, qf, p1, 0, 0, 0); }
#pragma unroll
    for (int dd = 0; dd < 4; ++dd) {
        bf16x8 b0 = *reinterpret_cast<const bf16x8*>(kr + dd * 32);
        bf16x8 b1 = *reinterpret_cast<const bf16x8*>(kr + dd * 32 + 32 * KRROWB);
        const bf16x8 qf = *(const volatile LAS bf16x8*)(qrl + (8 + dd - NQREG) * 1024);
        p0 = __builtin_amdgcn_mfma_f32_32x32x16_bf16(b0, qf, p0, 0, 0, 0);
        p1 = __builtin_amdgcn_mfma_f32_32x32x16_bf16(b1, qf, p1, 0, 0, 0); }
}
template <int VB>
__device__ __forceinline__ void pv_tile(f32x16* o, int vb0, bf16x8 pa0, bf16x8 pa1, bf16x8 pa2, bf16x8 pa3) {
#define TRRD(dst, off) asm volatile("ds_read_b64_tr_b16 %0, %1 offset:%2" : "=&v"(dst) : "v"(vb0), "i"(off) : "memory")
#define PV_D0(d0) do { s16x4 l0, l1, l2, l3, h0, h1, h2, h3; constexpr int b_ = OFF_V + VB * SHM_V + v_rd_off(d0, 0, 0); \
        TRRD(l0, b_); TRRD(h0, b_ + 2048); TRRD(l1, b_ + 4096); TRRD(h1, b_ + 6144); TRRD(l2, b_ + 8192); TRRD(h2, b_ + 10240); TRRD(l3, b_ + 12288); TRRD(h3, b_ + 14336); \
        asm volatile("s_waitcnt lgkmcnt(0)" ::: "memory"); SBAR();   \
        o[d0] = __builtin_amdgcn_mfma_f32_32x32x16_bf16(pa0, (bf16x8){l0[0], l0[1], l0[2], l0[3], h0[0], h0[1], h0[2], h0[3]}, o[d0], 0, 0, 0);   \
        o[d0] = __builtin_amdgcn_mfma_f32_32x32x16_bf16(pa1, (bf16x8){l1[0], l1[1], l1[2], l1[3], h1[0], h1[1], h1[2], h1[3]}, o[d0], 0, 0, 0);   \
        o[d0] = __builtin_amdgcn_mfma_f32_32x32x16_bf16(pa2, (bf16x8){l2[0], l2[1], l2[2], l2[3], h2[0], h2[1], h2[2], h2[3]}, o[d0], 0, 0, 0);   \
        o[d0] = __builtin_amdgcn_mfma_f32_32x32x16_bf16(pa3, (bf16x8){l3[0], l3[1], l3[2], l3[3], h3[0], h3[1], h3[2], h3[3]}, o[d0], 0, 0, 0); } while (0)
    PV_D0(0); PV_D0(1); PV_D0(2); PV_D0(3);
#undef PV_D0
#undef TRRD
}
struct BlockRef { const bf16_t* Q; const bf16_t* K; const bf16_t* KR; const bf16_t* V; bf16_t* O; int P0; };
#define VMW() asm volatile("s_waitcnt vmcnt(0)" ::: "memory")
#define GLD8(base, soff, voff) (*(const __attribute__((address_space(1))) bf16x8*)((const __attribute__((address_space(1))) char*)(base) + (size_t)(soff) + (voff)))
#define LOADK(k0) do { st_k0 = GLD8(cur.K, (size_t)(k0) * (KP * 2), kvoff); st_k1 = GLD8(cur.K, (size_t)((k0) + 32) * (KP * 2), kvoff);   \
                       st_kr = GLD8(cur.KR, (size_t)(k0) * (KRP * 2), krvoff); } while (0)
#define LOADV(k0) do { st_v0 = GLD8(cur.V, (size_t)(k0) * (VP * 2), kvoff); st_v1 = GLD8(cur.V, (size_t)((k0) + 32) * (VP * 2), kvoff); } while (0)
#define WRITEK(bf) do { *(bf16x8*)(lds + OFF_K + (bf) * SHM_K + kws) = st_k0; *(bf16x8*)(lds + OFF_K + (bf) * SHM_K + kws + 32 * KROWB) = st_k1; \
                        *(bf16x8*)(lds + OFF_KR + (bf) * SHM_KR + krws) = st_kr; } while (0)
#define WRITEV(bf) do { *(bf16x8*)(lds + OFF_V + (bf) * SHM_V + vst0) = st_v0; *(bf16x8*)(lds + OFF_V + (bf) * SHM_V + vst1) = st_v1; } while (0)
#define ABAR() do { asm volatile("s_waitcnt lgkmcnt(0)" ::: "memory"); __builtin_amdgcn_s_barrier(); asm volatile("" ::: "memory"); } while (0)
__device__ __forceinline__ void block(const BlockRef& cur, char* lds, const int tid) {
    const int wid = __builtin_amdgcn_readfirstlane(tid >> 6), lane = tid & 63, r32 = lane & 31, hi = lane >> 5, grp = wid >> 2;
    const int NT = (cur.P0 + QB) / KVBLK;
    const int qlo = cur.P0 + wid * QBLK, qm = qlo + r32 - 4 * hi;
    float* ws = (float*)(lds + OFF_WS) + wid * 64; float* li_l = ws, * al_l = ws + 32;
    float m_reg = -1e30f, l_reg = 0; f32x16 o[4] = {};
    const int sr = tid >> 4, sc = (tid & 15) * 8, vst0 = v_st(sr, sc), vst1 = v_st(32 + sr, sc), kws = KSWZ(sr, sc * 2);
    const int krr = tid >> 3, krc = (tid & 7) * 8, krws = KRSWZ(krr, krc * 2);
    const unsigned kvoff = (unsigned)(sr * KP + sc) * 2u, krvoff = (unsigned)(krr * KRP + krc) * 2u, qvoff = (unsigned)((wid * QBLK + r32) * QP + hi * 8) * 2u;
    const int vb0 = (int)(uintptr_t)lds + v_rd_base(lane);
    LAS char* qrl = (LAS char*)lds + OFF_QR + wid * (NQLDS * 1024) + lane * 16;
    bf16x8 qr[NQREG]; bf16x8 st_v0, st_v1, st_k0, st_k1, st_kr;
#pragma unroll
    for (int d0 = 0; d0 < NQREG; ++d0) qr[d0] = GLD8(cur.Q, d0 * 32, qvoff);
#pragma unroll
    for (int dd = 0; dd < NQLDS; ++dd) { const bf16x8 tq = GLD8(cur.Q, (NQREG + dd) * 32, qvoff); *(volatile LAS bf16x8*)(qrl + dd * 1024) = tq; }
    LOADK(0); VMW(); WRITEK(0);
    LOADK(KVBLK); LOADV(0);
    ABAR();
    if (grp) ABAR();
#define RESC(a) do { if (__any((a) < 1.f)) { if (hi == 0) al_l[r32] = (a); asm volatile("s_waitcnt lgkmcnt(0)" ::: "memory");              \
                     for (int d_ = 0; d_ < 4; ++d_) for (int r = 0; r < 16; ++r) o[d_][r] *= al_l[crow(r, hi)]; } } while (0)
#define KBASE(t) ((t) * KVBLK)
#define MASKT(P0_, P1_, t) do { const int kb_ = KBASE(t); if (kb_ + KVBLK - 1 > qlo) mask_tile(P0_, P1_, qm - kb_); } while (0)
    f32x16 p0, p1; bf16x8 pa0, pa1, pa2, pa3;
#define STEP(t, KB) do { float mn, al;                                                                                         \
        VMW(); if ((t) + 1 < NT) WRITEK((KB) ^ 1); WRITEV(KB);                                                                 \
        if ((t) + 2 < NT) LOADK(KBASE((t) + 2)); if ((t) + 1 < NT) LOADV(KBASE((t) + 1));                                      \
        SBAR(); qkt<KB>(p0, p1, lds, r32, hi, qr, qrl);                                                                        \
        if ((t) > 0) pv_tile<(KB) ^ 1>(o, vb0, pa0, pa1, pa2, pa3);                                                            \
        ABAR();                                                                                                                \
        MASKT(p0, p1, (t)); partialSM(p0, p1, m_reg, mn, al); RESC(al);                                                        \
        finishSM(p0, p1, al, l_reg, pa0, pa1, pa2, pa3);                                                                       \
        ABAR(); } while (0)
    for (int t = 0; t < NT; t += 2) { STEP(t, 0); STEP(t + 1, 1); }
    pv_tile<1>(o, vb0, pa0, pa1, pa2, pa3);
    if (!grp) ABAR();
    if (hi == 0) li_l[r32] = l_reg; asm volatile("s_waitcnt lgkmcnt(0)" ::: "memory");
    float rli[16];
#pragma unroll
    for (int r = 0; r < 16; ++r) rli[r] = __builtin_amdgcn_rcpf(li_l[crow(r, hi)]);
    bf16_t* Ow = cur.O + (size_t)(wid * QBLK) * OP;
#pragma unroll
    for (int r = 0; r < 16; ++r) { const int orow = crow(r, hi);
#pragma unroll
        for (int d0 = 0; d0 < 4; ++d0) { const float v = o[d0][r] * rli[r];
            const float vn = DPPF(v, 0xB1);
            if ((r32 & 1) == 0) *(unsigned*)(Ow + (size_t)orow * OP + d0 * 32 + r32) = cvt_pk_bf16(v, vn); } }
    ABAR();
#undef RESC
#undef KBASE
#undef MASKT
#undef STEP
}
#undef LOADK
#undef LOADV
#undef WRITEK
#undef WRITEV
#undef GLD8
__device__ __forceinline__ BlockRef mkref(int bh, int qb, const bf16_t* Q, const bf16_t* KV, const bf16_t* KR, bf16_t* O) {
    const int b = bh >> 3, h = bh & 7; BlockRef r;
    r.Q = Q + (size_t)(b * SEQ + qb * QB) * QP + h * 192; r.K = KV + (size_t)b * SEQ * KP + h * 128; r.KR = KR + (size_t)b * SEQ * KRP;
    r.V = KV + (size_t)b * SEQ * VP + 1024 + h * 128; r.O = O + (size_t)(b * SEQ + qb * QB) * OP + h * 128; r.P0 = qb * QB; return r;
}
__device__ __forceinline__ void attn_phase(char* lds, const bf16_t* Q, const bf16_t* KV, const bf16_t* KR, bf16_t* O, const int tid, const int bid) {
    for (int L = bid; L < 512; L += gridDim.x) {
        const int bh = (L >> 6) * 8 + (L & 7), x = (L >> 3) & 7;
        for (int pass = 0; pass < 2; ++pass) { const BlockRef cur = mkref(bh, pass ? x : 15 - x, Q, KV, KR, O); block(cur, lds, tid); }
    }
}
}

__device__ __forceinline__ void norm_rows(const float* x, const float* g1, const float* mods_l, int shi, int sci, bf16_t* o1, const float* g2, bf16_t* o2, int gw, int NGW, int lane) {
    f32x4 nx[4];
    if (gw < MT) { const f32x4* xr = (const f32x4*)(x + (size_t)gw * DM) + lane;
#pragma unroll
        for (int j = 0; j < 4; ++j) nx[j] = xr[64 * j]; }
    for (int m = gw; m < MT; m += NGW) {
        const int b = m >> 12;
        f32x4 v[4]; float s = 0.f;
#pragma unroll
        for (int j = 0; j < 4; ++j) v[j] = nx[j];
        if (m + NGW < MT) { const f32x4* xr = (const f32x4*)(x + (size_t)(m + NGW) * DM) + lane;
#pragma unroll
            for (int j = 0; j < 4; ++j) nx[j] = xr[64 * j]; }
#pragma unroll
        for (int j = 0; j < 4; ++j) s += (v[j].x * v[j].x + v[j].y * v[j].y) + (v[j].z * v[j].z + v[j].w * v[j].w);
        const float rstd = rsqrtf(wave_sum(s) * (1.f / DM) + EPS);
#pragma unroll
        for (int j = 0; j < 4; ++j) { const int col = 4 * lane + 256 * j; const f32x4 y = v[j] * rstd;
            f32x4 h = y * *(const f32x4*)(g1 + col);
            if (mods_l) { const f32x4 scv = *(const f32x4*)(mods_l + b * 6144 + sci * 1024 + col), shv = *(const f32x4*)(mods_l + b * 6144 + shi * 1024 + col); h = h * (scv + 1.0f) + shv; }
            u32x2 w; w.x = pk2(h.x, h.y); w.y = pk2(h.z, h.w); *(u32x2*)(o1 + (size_t)m * DM + col) = w;
            if (o2) { const f32x4 k = y * *(const f32x4*)(g2 + col); u32x2 w2; w2.x = pk2(k.x, k.y); w2.y = pk2(k.z, k.w); *(u32x2*)(o2 + (size_t)m * DM + col) = w2; } }
    }
}
__device__ __forceinline__ void norm_rows_b(const bf16_t* x, const float* g1, const float* mods_l, int shi, int sci, bf16_t* o1, const float* g2, bf16_t* o2, int gw, int NGW, int lane) {
    u32x4 nx[2];
    if (gw < MT) { const u32x4* xr = (const u32x4*)(x + (size_t)gw * DM) + lane; nx[0] = xr[0]; nx[1] = xr[64]; }
    for (int m = gw; m < MT; m += NGW) {
        const int b = m >> 12;
        u32x4 raw[2] = {nx[0], nx[1]};
        if (m + NGW < MT) { const u32x4* xr = (const u32x4*)(x + (size_t)(m + NGW) * DM) + lane; nx[0] = xr[0]; nx[1] = xr[64]; }
        float v[2][8]; float s = 0.f;
#pragma unroll
        for (int j = 0; j < 2; ++j)
#pragma unroll
            for (int q = 0; q < 4; ++q) { v[j][2 * q] = bflo(raw[j][q]); v[j][2 * q + 1] = bfhi(raw[j][q]); s += v[j][2 * q] * v[j][2 * q] + v[j][2 * q + 1] * v[j][2 * q + 1]; }
        const float rstd = rsqrtf(wave_sum(s) * (1.f / DM) + EPS);
#pragma unroll
        for (int j = 0; j < 2; ++j) { const int col = 8 * lane + 512 * j;
            const f32x4 ga = *(const f32x4*)(g1 + col), gb = *(const f32x4*)(g1 + col + 4);
            f32x4 ya = (f32x4){v[j][0], v[j][1], v[j][2], v[j][3]} * rstd, yb = (f32x4){v[j][4], v[j][5], v[j][6], v[j][7]} * rstd;
            f32x4 ha = ya * ga, hb = yb * gb;
            if (mods_l) { const float* sp = mods_l + b * 6144 + sci * 1024 + col; const float* hp = mods_l + b * 6144 + shi * 1024 + col;
                ha = ha * (*(const f32x4*)sp + 1.0f) + *(const f32x4*)hp; hb = hb * (*(const f32x4*)(sp + 4) + 1.0f) + *(const f32x4*)(hp + 4); }
            u32x4 w; w.x = pk2(ha.x, ha.y); w.y = pk2(ha.z, ha.w); w.z = pk2(hb.x, hb.y); w.w = pk2(hb.z, hb.w); *(u32x4*)(o1 + (size_t)m * DM + col) = w;
            if (o2) { const f32x4 ka = ya * *(const f32x4*)(g2 + col), kb = yb * *(const f32x4*)(g2 + col + 4);
                u32x4 w2; w2.x = pk2(ka.x, ka.y); w2.y = pk2(ka.z, ka.w); w2.z = pk2(kb.x, kb.y); w2.w = pk2(kb.z, kb.w); *(u32x4*)(o2 + (size_t)m * DM + col) = w2; } }
    }
}
__device__ __forceinline__ void ld8f(const bf16_t* p, float* v) { const u32x4 u = *(const u32x4*)p;
#pragma unroll
    for (int q = 0; q < 4; ++q) { v[2 * q] = bflo(u[q]); v[2 * q + 1] = bfhi(u[q]); } }
__device__ __forceinline__ void pooled_phase(const bf16_t* h, bf16_t* out, int gtid, int NT_) {
    for (int job = gtid; job < (MT / 32) * 128; job += NT_) {
        const int col = (job & 127) * 8, row0 = (job >> 7) * 32, w = 2 << (col >> 8), t0 = row0 & (SEQ - 1);
        const bf16_t* hp = h + (size_t)row0 * DM + col; bf16_t* op = out + (size_t)row0 * DM + col;
        float s[8];
#pragma unroll
        for (int q = 0; q < 8; ++q) s[q] = 0.f;
        const int nwarm = (t0 < w) ? t0 : w;
        for (int k = 1; k <= nwarm; ++k) { float v[8]; ld8f(hp - (size_t)k * DM, v);
#pragma unroll
            for (int q = 0; q < 8; ++q) s[q] += v[q]; }
#pragma unroll 4
        for (int r = 0; r < 32; ++r) { const int t = t0 + r; float cur[8]; ld8f(hp + (size_t)r * DM, cur);
#pragma unroll
            for (int q = 0; q < 8; ++q) s[q] += cur[q];
            if (t >= w) { float old[8]; ld8f(hp + (size_t)(r - w) * DM, old);
#pragma unroll
                for (int q = 0; q < 8; ++q) s[q] -= old[q]; }
            const float inv = 1.0f / (float)((t + 1 < w) ? t + 1 : w);
            u32x4 o;
#pragma unroll
            for (int q = 0; q < 4; ++q) o[q] = pk2(s[2 * q] * inv - cur[2 * q], s[2 * q + 1] * inv - cur[2 * q + 1]);
            *(u32x4*)(op + (size_t)r * DM) = o; }
    }
}
template <bool F32IN>
__device__ __forceinline__ void load8x(const void* x, size_t row, int col, float* v) {
    if (F32IN) { const GAS f32x4* p = (const GAS f32x4*)((const float*)x + row * DM + col); const f32x4 a = p[0], b = p[1]; v[0] = a.x; v[1] = a.y; v[2] = a.z; v[3] = a.w; v[4] = b.x; v[5] = b.y; v[6] = b.z; v[7] = b.w; }
    else { const u32x4 u = *(const GAS u32x4*)((const bf16_t*)x + row * DM + col);
#pragma unroll
        for (int q = 0; q < 4; ++q) { v[2 * q] = bflo(u[q]); v[2 * q + 1] = bfhi(u[q]); } }
}
template <bool F32IN>
__device__ __forceinline__ void normpool_phase(const void* x, const float* g, const float* mods_l, bf16_t* out, LAS float* rs, int bid, int G, int tid) {
    const int wave = tid >> 6, lane = tid & 63;
    for (int blk = bid; blk < MT / 64; blk += G) {
        const int row0 = blk * 64, t0 = row0 & (SEQ - 1), b = row0 >> 12;
#pragma unroll 2
        for (int j = 0; j < 10; ++j) { const int i = wave + 8 * j, t = t0 - 16 + i;
            if (t >= 0) { float v0[8], v1[8]; load8x<F32IN>(x, (size_t)(row0 - 16 + i), 8 * lane, v0); load8x<F32IN>(x, (size_t)(row0 - 16 + i), 512 + 8 * lane, v1);
                float s = 0.f;
#pragma unroll
                for (int q = 0; q < 8; ++q) s += v0[q] * v0[q] + v1[q] * v1[q];
                const float rstd = rsqrtf(wave_sum(s) * (1.f / DM) + EPS); if (lane == 0) rs[i] = rstd; } }
        __syncthreads();
        { const int col = (tid & 127) * 8, rq = tid >> 7, w = 2 << (col >> 8), tb = t0 + 16 * rq;
          float gm[8], sh[8];
          { const GAS f32x4* gp = (const GAS f32x4*)(g + col); const GAS f32x4* sp = (const GAS f32x4*)(mods_l + b * 6144 + 1024 + col); const GAS f32x4* hp = (const GAS f32x4*)(mods_l + b * 6144 + col);
#pragma unroll
            for (int q = 0; q < 2; ++q) { const f32x4 gg = gp[q], sc = sp[q], hh = hp[q];
#pragma unroll
                for (int e = 0; e < 4; ++e) { gm[4 * q + e] = gg[e] * (1.f + sc[e]); sh[4 * q + e] = hh[e]; } } }
          float s[8];
#pragma unroll
          for (int q = 0; q < 8; ++q) s[q] = 0.f;
          const int nwarm = (tb < w) ? tb : w;
          const size_t rbase = (size_t)row0 + 16 * rq; const int ib = 16 + 16 * rq;
          for (int k = 1; k <= nwarm; ++k) { float v[8]; load8x<F32IN>(x, rbase - k, col, v); const float rr = rs[ib - k];
#pragma unroll
              for (int q = 0; q < 8; ++q) s[q] += v[q] * rr * gm[q] + sh[q]; }
#pragma unroll 4
          for (int r = 0; r < 16; ++r) { const int t = tb + r; float cur[8]; load8x<F32IN>(x, rbase + r, col, cur); const float rr = rs[ib + r];
#pragma unroll
              for (int q = 0; q < 8; ++q) { cur[q] = cur[q] * rr * gm[q] + sh[q]; s[q] += cur[q]; }
              if (t >= w) { float old[8]; load8x<F32IN>(x, rbase + r - w, col, old); const float ro = rs[ib + r - w];
#pragma unroll
                  for (int q = 0; q < 8; ++q) s[q] -= old[q] * ro * gm[q] + sh[q]; }
              const float inv = 1.0f / (float)((t + 1 < w) ? t + 1 : w);
              u32x4 o;
#pragma unroll
              for (int q = 0; q < 4; ++q) o[q] = pk2(s[2 * q] * inv - cur[2 * q], s[2 * q + 1] * inv - cur[2 * q + 1]);
              *(GAS u32x4*)(out + (rbase + r) * DM + col) = o; } }
        __syncthreads();
    }
}
__device__ __forceinline__ void cq_norm(const bf16_t* raw, const float* g, bf16_t* out, int gw, int NGW, int lane) {
    u32x2 na = {0u, 0u}, nc = {0u, 0u};
    if (gw < MT) { const bf16_t* r = raw + (size_t)gw * 512; na = *(const u32x2*)(r + 4 * lane); if (lane < 32) nc = *(const u32x2*)(r + 256 + 4 * lane); }
    for (int m = gw; m < MT; m += NGW) {
        const u32x2 a = na, c = nc;
        if (m + NGW < MT) { const bf16_t* r = raw + (size_t)(m + NGW) * 512; na = *(const u32x2*)(r + 4 * lane); if (lane < 32) nc = *(const u32x2*)(r + 256 + 4 * lane); }
        float v[8] = {bflo(a.x), bfhi(a.x), bflo(a.y), bfhi(a.y), bflo(c.x), bfhi(c.x), bflo(c.y), bfhi(c.y)};
        float s = 0.f;
#pragma unroll
        for (int q = 0; q < 8; ++q) s += v[q] * v[q];
        const float rstd = rsqrtf(wave_sum(s) * (1.f / 384.f) + EPS);
        const f32x4 g0 = *(const f32x4*)(g + 4 * lane);
        u32x2 w; w.x = pk2(v[0] * rstd * g0.x, v[1] * rstd * g0.y); w.y = pk2(v[2] * rstd * g0.z, v[3] * rstd * g0.w);
        *(u32x2*)(out + (size_t)m * 384 + 4 * lane) = w;
        if (lane < 32) { const f32x4 g1 = *(const f32x4*)(g + 256 + 4 * lane); u32x2 w2; w2.x = pk2(v[4] * rstd * g1.x, v[5] * rstd * g1.y); w2.y = pk2(v[6] * rstd * g1.z, v[7] * rstd * g1.w);
            *(u32x2*)(out + (size_t)m * 384 + 256 + 4 * lane) = w2; }
    }
}
__device__ __forceinline__ void ckv_norm(const bf16_t* raw, const float* g, const float* cs, bf16_t* ckv, bf16_t* kr, int gw, int NGW, int lane) {
    u32x2 na = {0u, 0u}; unsigned np = 0u; f32x2 ncs = {0.f, 0.f};
    if (gw < MT) { const bf16_t* r = raw + (size_t)gw * 512; na = *(const u32x2*)(r + 4 * lane); if (lane < 32) { np = *(const unsigned*)(r + 256 + 2 * lane); ncs = *(const f32x2*)(cs + (size_t)gw * 64 + 2 * lane); } }
    for (int m = gw; m < MT; m += NGW) {
        const u32x2 a = na; const unsigned p = np; const f32x2 c = ncs;
        if (m + NGW < MT) { const bf16_t* r = raw + (size_t)(m + NGW) * 512; na = *(const u32x2*)(r + 4 * lane); if (lane < 32) { np = *(const unsigned*)(r + 256 + 2 * lane); ncs = *(const f32x2*)(cs + (size_t)(m + NGW) * 64 + 2 * lane); } }
        const float v0 = bflo(a.x), v1 = bfhi(a.x), v2 = bflo(a.y), v3 = bfhi(a.y);
        const float rstd = rsqrtf(wave_sum(v0 * v0 + v1 * v1 + v2 * v2 + v3 * v3) * (1.f / 256.f) + EPS);
        const f32x4 g0 = *(const f32x4*)(g + 4 * lane);
        u32x2 w; w.x = pk2(v0 * rstd * g0.x, v1 * rstd * g0.y); w.y = pk2(v2 * rstd * g0.z, v3 * rstd * g0.w);
        *(u32x2*)(ckv + (size_t)m * 256 + 4 * lane) = w;
        if (lane < 32) { const float x1 = bflo(p), x2 = bfhi(p);
            *(unsigned*)(kr + (size_t)m * 64 + 2 * lane) = pk2(x1 * c.x - x2 * c.y, x2 * c.x + x1 * c.y); }
    }
}
__device__ __forceinline__ int col_map(int kind, int n) {
    if (kind == 0) return n;
    if (kind == 1) { const int pn = n >> 8, r = n & 255; return (r >> 7) * FF + 128 * pn + (r & 127); }
    if (kind == 2) { if (n < 256) return n; if (n < 320) { const int i = n - 256; return 256 + (i >> 1) + (i & 1) * 32; } return -1; }
    if (kind == 3) { const int h = n / 192, r = n - h * 192; if (r < 128) return n; const int i = r - 128; return h * 192 + 128 + (i >> 1) + (i & 1) * 32; }
    return n < 384 ? n : -1;
}
__device__ __forceinline__ void tr_item(const float* W, int K, int N, bf16_t* WT, int nblk, int kind, LAS float* scr, int item, int lane) {
    const int kb = item / nblk, nb = item - kb * nblk, k0 = 64 * kb, n0 = 32 * nb;
    const int src = col_map(kind, n0 + (lane & 31));
#pragma unroll
    for (int i = 0; i < 32; ++i) { const int kk = 2 * i + (lane >> 5); scr[kk * 33 + (lane & 31)] = src >= 0 ? W[(size_t)(k0 + kk) * N + src] : 0.f; }
    LDS_WAIT(); asm volatile("" ::: "memory");
    const int c = lane & 7;
#pragma unroll
    for (int j = 0; j < 4; ++j) { const int n = (lane >> 3) + 8 * j; const LAS float* s = scr + (8 * c) * 33 + n;
        u32x4 o; o.x = pk2(s[0 * 33], s[1 * 33]); o.y = pk2(s[2 * 33], s[3 * 33]); o.z = pk2(s[4 * 33], s[5 * 33]); o.w = pk2(s[6 * 33], s[7 * 33]);
        *(u32x4*)(WT + (size_t)(n0 + n) * K + k0 + 8 * c) = o; }
    LDS_WAIT(); asm volatile("" ::: "memory");
}
struct Seg { const float* W; bf16_t* WT; int K, N, Nout, kind; };
__device__ __forceinline__ Seg get_seg(ArgsP a, int s) {
    unsigned char* ws = a->ws; ASSUME_GLOBAL(ws); Seg g;
    if (s < 4) { g.W = AF(w_up) + (size_t)s * 1024 * 5632; g.WT = (bf16_t*)(ws + WS_WUP); g.K = 1024; g.N = 5632; g.Nout = 5632; g.kind = 1; }
    else if (s < 8) { const int l = s - 4; g.W = AF(w_down) + (size_t)l * FF * 1024; g.WT = (bf16_t*)(ws + WS_WDN); g.K = FF; g.N = 1024; g.Nout = 1024; g.kind = 0; }
    else if (s < 16) { const int i = s - 8; g.W = AF(pool_w) + (size_t)i * 65536; g.WT = (bf16_t*)(ws + WS_WPOOL) + (size_t)i * 65536; g.K = 256; g.N = 256; g.Nout = 256; g.kind = 0; }
    else if (s == 16) { g.W = AF(w_dkv); g.WT = (bf16_t*)(ws + WS_WDKV); g.K = 1024; g.N = 320; g.Nout = 512; g.kind = 2; }
    else if (s == 17) { g.W = AF(w_uk); g.WT = (bf16_t*)(ws + WS_WKV); g.K = 256; g.N = 1024; g.Nout = 1024; g.kind = 0; }
    else if (s == 18) { g.W = AF(w_uv); g.WT = (bf16_t*)(ws + WS_WKV) + (size_t)1024 * 256; g.K = 256; g.N = 1024; g.Nout = 1024; g.kind = 0; }
    else if (s < 21) { const int j = s - 19; g.W = AF(w_dq) + (size_t)j * 1024 * 384; g.WT = (bf16_t*)(ws + WS_WDQ) + (size_t)j * 512 * 1024; g.K = 1024; g.N = 384; g.Nout = 512; g.kind = 4; }
    else if (s < 23) { const int j = s - 21; g.W = AF(w_uq) + (size_t)j * 384 * 1536; g.WT = (bf16_t*)(ws + WS_WUQ + j * WUQ_SZ); g.K = 384; g.N = 1536; g.Nout = 1536; g.kind = 3; }
    else { const int j = s - 23; g.W = AF(w_o) + (size_t)j * 1024 * 1024; g.WT = (bf16_t*)(ws + WS_WO) + (size_t)j * 1024 * 1024; g.K = 1024; g.N = 1024; g.Nout = 1024; g.kind = 0; }
    return g;
}
constexpr int NSEG = 25;
__device__ __forceinline__ void prep_phase(ArgsP a, LAS unsigned char* lds, int tid, int lane, int wave, int bid) {
    unsigned char* wsp_ = a->ws; ASSUME_GLOBAL(wsp_); float* mods = (float*)(wsp_ + WS_MODS);
    LAS float* sl = (LAS float*)lds; LAS float* red = (LAS float*)(lds + 32768);
    for (int i = tid; i < NB * DM; i += NTHR) { const float v = AF(c)[i]; sl[i] = v / (1.f + __expf(-v)); }
    __syncthreads();
    for (int it = bid; it < 4 * 192; it += gridDim.x) {
        const int l = it / 192, e0 = (it - l * 192) * 32, c = lane & 31, kh = lane >> 5;
        const float* W = AF(mod_w) + (size_t)l * DM * 6144 + e0 + c;
        float acc[8];
#pragma unroll
        for (int b = 0; b < 8; ++b) acc[b] = 0.f;
        const int kbeg = wave * 128 + kh;
#pragma unroll 16
        for (int k = kbeg; k < kbeg + 128; k += 2) { const float wv = W[(size_t)k * 6144];
#pragma unroll
            for (int b = 0; b < 8; ++b) acc[b] += sl[b * DM + k] * wv; }
#pragma unroll
        for (int b = 0; b < 8; ++b) red[(wave * 8 + b) * 64 + lane] = acc[b];
        __syncthreads();
        if (tid < 256) { const int b = tid >> 5, cc = tid & 31; float s = AF(mod_b)[l * 6144 + e0 + cc];
#pragma unroll
          for (int w = 0; w < 8; ++w) s += red[(w * 8 + b) * 64 + cc] + red[(w * 8 + b) * 64 + 32 + cc];
          mods[(size_t)(l * 8 + b) * 6144 + e0 + cc] = s; }
        __syncthreads();
    }
    { float* cs = (float*)(wsp_ + WS_CS); const int gtid = bid * NTHR + tid, NT_ = gridDim.x * NTHR;
      for (int idx = gtid; idx < MT * 32; idx += NT_) { const int row = idx >> 5, i = idx & 31;
          const float inv = exp2f(-(float)i * 0.41524101186092029f);
          const double rev = (double)AI(pos)[row] * (double)inv * 0.15915494309189535; const float fr = (float)(rev - floor(rev));
          f32x2 o; o.x = __builtin_amdgcn_cosf(fr); o.y = __builtin_amdgcn_sinf(fr); *(f32x2*)(cs + (size_t)idx * 2) = o; } }
    __syncthreads();
    LAS float* scr = (LAS float*)(lds + wave * 16384);
    const int gw = bid * NWAVES + wave, NGW = gridDim.x * NWAVES;
    int base = 0;
    for (int s = 8; s < NSEG; ++s) {
        const Seg g = get_seg(a, s); const int nblk = g.Nout / 32, nit = (g.K / 64) * nblk;
        int first = (gw - base % NGW + NGW) % NGW;
        for (int it = first; it < nit; it += NGW) tr_item(g.W, g.K, g.N, g.WT, nblk, g.kind, scr, it, lane);
        base += nit;
    }
}
__device__ __forceinline__ void ffn_weights(ArgsP a, LAS unsigned char* lds, int l, int lane, int wave, int bid) {
    LAS float* scr = (LAS float*)(lds + wave * 16384);
    const int gw = bid * NWAVES + wave, NGW = gridDim.x * NWAVES;
    int base = 0;
    for (int q = 0; q < 2; ++q) {
        const Seg g = get_seg(a, q ? 4 + l : l); const int nblk = g.Nout / 32, nit = (g.K / 64) * nblk;
        int first = (gw - base % NGW + NGW) % NGW;
        for (int it = first; it < nit; it += NGW) tr_item(g.W, g.K, g.N, g.WT, nblk, g.kind, scr, it, lane);
        base += nit;
    }
}
__device__ __forceinline__ void final_norm(const bf16_t* x, float* out, const float* g, int gw, int NGW, int lane) {
    u32x4 nx[2];
    if (gw < MT) { const u32x4* xr = (const u32x4*)(x + (size_t)gw * DM) + lane; nx[0] = xr[0]; nx[1] = xr[64]; }
    for (int m = gw; m < MT; m += NGW) {
        u32x4 raw[2] = {nx[0], nx[1]};
        if (m + NGW < MT) { const u32x4* xr = (const u32x4*)(x + (size_t)(m + NGW) * DM) + lane; nx[0] = xr[0]; nx[1] = xr[64]; }
        float v[2][8]; float s = 0.f;
#pragma unroll
        for (int j = 0; j < 2; ++j)
#pragma unroll
            for (int q = 0; q < 4; ++q) { v[j][2 * q] = bflo(raw[j][q]); v[j][2 * q + 1] = bfhi(raw[j][q]); s += v[j][2 * q] * v[j][2 * q] + v[j][2 * q + 1] * v[j][2 * q + 1]; }
        const float rstd = rsqrtf(wave_sum(s) * (1.f / DM) + EPS);
#pragma unroll
        for (int j = 0; j < 2; ++j) { const int col = 8 * lane + 512 * j; float* o = out + (size_t)m * DM + col;
            *(f32x4*)o = (f32x4){v[j][0], v[j][1], v[j][2], v[j][3]} * rstd * *(const f32x4*)(g + col);
            *(f32x4*)(o + 4) = (f32x4){v[j][4], v[j][5], v[j][6], v[j][7]} * rstd * *(const f32x4*)(g + col + 4); }
    }
}


enum { K_PREP = 0, K_NORM1, K_POOLED, K_GPOOL, K_NORM2, K_GUP, K_GDOWN, K_NORMA, K_GEMMA, K_NORMB, K_GEMMB, K_ATTN, K_GWO, K_FINAL };
constexpr int NPHASE = 1 + 2 * 5 + 2 * 9 + 1;
__device__ __forceinline__ void phase_of(int ph, int& kind, int& l) {
    if (ph == 0) { kind = K_PREP; l = 0; return; }
    if (ph <= 10) { l = (ph - 1) / 5; const int k = (ph - 1) - l * 5; kind = (k == 0) ? K_NORM1 : (k == 1) ? K_GPOOL : (k == 2) ? K_NORM2 : (k == 3) ? K_GUP : K_GDOWN; return; }
    if (ph <= 28) { const int q = (ph - 11) / 9, k = (ph - 11) - q * 9; l = 2 + q;
        kind = (k == 0) ? K_NORMA : (k == 1) ? K_GEMMA : (k == 2) ? K_NORMB : (k == 3) ? K_GEMMB : (k == 4) ? K_ATTN : (k == 5) ? K_GWO : (k == 6) ? K_NORM2 : (k == 7) ? K_GUP : K_GDOWN; return; }
    kind = K_FINAL; l = 3;
}


#define XB_TMO      128
#define XB_XCNT(j)  (256  + 64 * (j))
#define XB_XSUB(j)  (1280 + 64 * (j))
#define XB_XGEN(j)  (2304 + 64 * (j))
#define XB_TOP      3328
#define XB_TOPGEN   3392
#define XCD_BAR_WORDS 3456
#define XB_SPIN_CAP (1u << 22)
constexpr size_t WS_BAR = 10 * MiB;
__device__ __forceinline__ unsigned xb_ld(unsigned* p)              { return __hip_atomic_load(p, __ATOMIC_RELAXED, __HIP_MEMORY_SCOPE_AGENT); }
__device__ __forceinline__ unsigned xb_add(unsigned* p, unsigned v) { return __hip_atomic_fetch_add(p, v, __ATOMIC_RELAXED, __HIP_MEMORY_SCOPE_AGENT); }
__device__ __forceinline__ unsigned xb_xcc_id() { return (unsigned)__builtin_amdgcn_s_getreg((3 << 11) | 20) & 0xFu; }
#define XB_SPIN(cond, bar) do { unsigned _sp = 0; while (cond) { __builtin_amdgcn_s_sleep(1); \
    if ((++_sp & 255u) == 0u) { if (xb_ld(&(bar)[XB_TMO])) break; if (_sp > XB_SPIN_CAP) { atomicAdd(&(bar)[XB_TMO], 1u); break; } } } } while (0)
__device__ __forceinline__ void xcd_barrier_complete(unsigned* bar, unsigned x, unsigned& nloc, unsigned& nx) {
    const unsigned G = gridDim.x;
    unsigned sum, cnt, mine, sp = 0u;
    for (;;) {
        sum = 0u; cnt = 0u; mine = 0u;
#pragma unroll
        for (unsigned j = 0; j < 16; ++j) { const unsigned c = xb_ld(&bar[XB_XCNT(j)]); sum += c; cnt += (c > 0u) ? 1u : 0u; mine = (j == x) ? c : mine; }
        if (sum == G) break;
        __builtin_amdgcn_s_sleep(1);
        if ((++sp & 255u) == 0u) { if (xb_ld(&bar[XB_TMO])) break; if (sp > XB_SPIN_CAP) { atomicAdd(&bar[XB_TMO], 1u); break; } }
    }
    nloc = mine > 0u ? mine : 1u; nx = cnt > 0u ? cnt : 1u;
}
__device__ __forceinline__ void xcd_barrier(unsigned* bar, unsigned x, volatile LAS unsigned* st, bool leader_thread) {
    asm volatile("s_waitcnt vmcnt(0)" ::: "memory");
    __syncthreads();
    if (leader_thread) {
        __builtin_amdgcn_s_waitcnt(0);
        unsigned nloc = st[0], nx = st[1];
        if (nloc == 0u) { xcd_barrier_complete(bar, x, nloc, nx); st[0] = nloc; st[1] = nx; }
        const unsigned old = xb_add(&bar[XB_XSUB(x)], 1u);
        const unsigned gen = old / nloc;
        if (old + 1u == (gen + 1u) * nloc) {
            __builtin_amdgcn_fence(__ATOMIC_RELEASE, "agent");
            asm volatile("s_waitcnt vmcnt(0)" ::: "memory");
            const unsigned og = xb_add(&bar[XB_TOP], 1u);
            const unsigned tg = og / nx;
            if (og + 1u == (tg + 1u) * nx) xb_add(&bar[XB_TOPGEN], 1u);
            else XB_SPIN(xb_ld(&bar[XB_TOPGEN]) == tg, bar);
            __builtin_amdgcn_fence(__ATOMIC_ACQUIRE, "agent");
            xb_add(&bar[XB_XGEN(x)], 1u);
            asm volatile("s_waitcnt vmcnt(0)" ::: "memory");
        } else {
            XB_SPIN(xb_ld(&bar[XB_XGEN(x)]) == gen, bar);
            __builtin_amdgcn_fence(__ATOMIC_ACQUIRE, "agent");
            asm volatile("s_waitcnt vmcnt(0)" ::: "memory");
        }
    }
    __syncthreads();
}

__global__ void __launch_bounds__(NTHR, 2) fwd_megakernel(Args a_unused) {
    extern __shared__ __attribute__((aligned(16))) unsigned char lds_raw[];
    cg::grid_group grid = cg::this_grid();
    LAS unsigned char* lds = (LAS unsigned char*)lds_raw;
    LAS unsigned char* xl = lds + XCH_OFF;
    const int G = gridDim.x, NGW = G * NWAVES;
    volatile LAS unsigned* bst = (volatile LAS unsigned*)(lds + LDS_BYTES - 16);
    if (threadIdx.x == 0) { bst[0] = 0u; bst[1] = 0u; (void)xb_add((unsigned*)(a_unused.ws + WS_BAR) + XB_XCNT(xb_xcc_id()), 1u); }
    __syncthreads();
    grid.sync();
    const int wave0 = __builtin_amdgcn_readfirstlane(threadIdx.x >> 6);
    for (int ph = 0; ph < NPHASE; ++ph) {
        ArgsP a = (ArgsP)__builtin_amdgcn_kernarg_segment_ptr(); asm volatile("" : "+s"(a));
        int wv = wave0; asm volatile("" : "+s"(wv));
#define TIDNOW() ([&]() { int t_; asm volatile("v_mbcnt_lo_u32_b32 %0, -1, 0\n\tv_mbcnt_hi_u32_b32 %0, -1, %0" : "=v"(t_)); return t_ + wv * 64; })()
        const int tid = TIDNOW();
        int bid = blockIdx.x; asm volatile("" : "+s"(bid));
        unsigned char* ws = a->ws; asm volatile("" : "+s"(ws)); ASSUME_GLOBAL(ws);
        float* outp = a->out; asm volatile("" : "+s"(outp)); ASSUME_GLOBAL(outp);
        const int lane = tid & 63, wave = __builtin_amdgcn_readfirstlane(tid >> 6), gw = bid * NWAVES + wave;
        float* mods = (float*)(ws + WS_MODS); const float* cs = (const float*)(ws + WS_CS);
        bf16_t* XB = (bf16_t*)(ws + WS_XB); bf16_t* Hb = (bf16_t*)(ws + WS_H); bf16_t* KVb = (bf16_t*)(ws + WS_KV); bf16_t* KRb = (bf16_t*)(ws + WS_KR); unsigned char* ACT = ws + WS_ACT;
        int kind, l; phase_of(ph, kind, l);
        const float* mods_l = mods + (size_t)l * 8 * 6144;
        const int j = l - 2;
        switch (kind) {
        case K_PREP: { const int tid_ = TIDNOW(); prep_phase(a, lds, tid_, tid_ & 63, wave, bid); } break;
        case K_NORM1: { const int tid_ = TIDNOW();
                        if (l == 0) normpool_phase<true>(AF(x), AF(norm1_g) + l * DM, mods_l, (bf16_t*)ACT, (LAS float*)lds, bid, G, tid_);
                        else normpool_phase<false>(XB, AF(norm1_g) + l * DM, mods_l, (bf16_t*)ACT, (LAS float*)lds, bid, G, tid_); } break;
        case K_NORM2: norm_rows_b(XB, AF(norm2_g) + l * DM, mods_l, 3, 4, Hb, nullptr, nullptr, gw, NGW, lane); ffn_weights(a, lds, l, lane, wave, bid); break;
        case K_POOLED: pooled_phase(Hb, (bf16_t*)ACT, bid * NTHR + TIDNOW(), G * NTHR); break;
        case K_NORMA: norm_rows_b(XB, AF(norm1_g) + l * DM, mods_l, 0, 1, (bf16_t*)(ACT + ACT_Q), AF(kv_in_g), (l == 2) ? Hb : nullptr, gw, NGW, lane); break;
        case K_NORMB:
            cq_norm((const bf16_t*)(ACT + ACT_CQRAW), AF(q_norm_g) + j * 384, Hb, gw, NGW, lane);
            if (l == 2) ckv_norm((const bf16_t*)(ACT + ACT_KVRAW), AF(ckv_norm_g), cs, (bf16_t*)(ACT + ACT_CKV), KRb, gw, NGW, lane);
            break;
        case K_GPOOL: case K_GDOWN: case K_GWO: {
            pg8::Gemm g; pg8::EpiRes E; E.out = XB; E.base = XB; E.base_f32 = 0; E.pb = nullptr; E.ps = nullptr;
            if (kind == K_GPOOL) { g = pg8::Gemm{(const bf16_t*)ACT, (const bf16_t*)(ws + WS_WPOOL) + (size_t)l * 4 * 65536, 1024, 256, 256}; if (l == 0) { E.base = AF(x); E.base_f32 = 1; } E.gate = mods_l + 2 * 1024; E.pb = AF(pool_b) + l * DM; E.ps = AF(pool_scale) + l * DM; }
            else if (kind == K_GDOWN) { g = pg8::Gemm{(const bf16_t*)ACT, (const bf16_t*)(ws + WS_WDN), FF, FF, 0}; E.gate = mods_l + 5 * 1024; }
            else { g = pg8::Gemm{(const bf16_t*)(ACT + ACT_O), (const bf16_t*)(ws + WS_WO) + (size_t)j * 1024 * 1024, 1024, 1024, 0}; E.gate = mods_l + 2 * 1024; }
            pg8::Order S; S.init(128, 4, G, bid);
            if (kind == K_GDOWN) {
                const float* cw = AF(conv_w) + (size_t)l * 3 * FF; const float* cb = AF(conv_b) + (size_t)l * FF;
                const float* topa = (const float*)(ws + WS_TOPA); const float* topv = (const float*)(ws + WS_TOPV); const float* bota = (const float*)(ws + WS_BOTA); bf16_t* act = (bf16_t*)ACT;
                for (int i = 0; ; ++i) { pg8::Unit u; if (!S.next(i, u)) break; if ((u.pm & 15) == 0) continue;
                    for (int e = TIDNOW(); e < 2 * FF; e += NTHR) { const int i2 = e >= FF ? 1 : 0, f = e - i2 * FF;
                        const float b0 = bota[(size_t)((u.pm - 1) * 2) * FF + f], b1 = bota[(size_t)((u.pm - 1) * 2 + 1) * FF + f], t0v = topa[(size_t)(u.pm * 2) * FF + f], t1v = topa[(size_t)(u.pm * 2 + 1) * FF + f];
                        const float am2 = i2 ? b1 : b0, am1 = i2 ? t0v : b1, cur = i2 ? t1v : t0v, v = topv[(size_t)(u.pm * 2 + i2) * FF + f];
                        const float ac = cw[f] * am2 + cw[FF + f] * am1 + cw[2 * FF + f] * cur + cb[f];
                        const f32x2 gg = pg8::gelu_pk((f32x2){ac, ac});
                        act[(size_t)(u.pm * 256 + i2) * FF + f] = (bf16_t)f2bf(gg.x * v); } }
                asm volatile("s_waitcnt vmcnt(0)" ::: "memory"); __syncthreads();
            }
            pg8::gemm_phase<pg8::EpiRes, 0>(lds, xl, g, S, E, TIDNOW());
        } break;
        case K_GUP: {
            pg8::Gemm g{Hb, (const bf16_t*)(ws + WS_WUP), 1024, 1024, 0};
            pg8::EpiUp E{(bf16_t*)ACT, AF(conv_w) + (size_t)l * 3 * FF, AF(conv_b) + (size_t)l * FF, (float*)(ws + WS_TOPA), (float*)(ws + WS_TOPV), (float*)(ws + WS_BOTA)};
            pg8::Order S; S.init(128, 22, G, bid);
            pg8::gemm_phase<pg8::EpiUp, 0>(lds, xl, g, S, E, TIDNOW());
        } break;
        case K_GEMMA: case K_GEMMB: {
            if (kind == K_GEMMB) {
                pg8::Gemm g{Hb, (const bf16_t*)(ws + WS_WUQ + j * WUQ_SZ), 384, 384, 0};
                pg8::EpiQ E{(bf16_t*)(ACT + ACT_Q), cs};
                pg8::Order S; S.init(128, 6, G, bid);
                pg8::gemm_phase<pg8::EpiQ, 0>(lds, xl, g, S, E, TIDNOW());
            }
            const int ng = (kind == K_GEMMA) ? (l == 2 ? 2 : 1) : (l == 2 ? 1 : 0);
            for (int i = 0; i < ng; ++i) {
                pg8::Gemm g; pg8::EpiBf16 E; int nN;
                if (kind == K_GEMMA && i == 0) { g = pg8::Gemm{(const bf16_t*)(ACT + ACT_Q), (const bf16_t*)(ws + WS_WDQ) + (size_t)j * 512 * 1024, 1024, 1024, 0}; E = pg8::EpiBf16{(bf16_t*)(ACT + ACT_CQRAW), 512}; nN = 2; }
                else if (kind == K_GEMMA) { g = pg8::Gemm{Hb, (const bf16_t*)(ws + WS_WDKV), 1024, 1024, 0}; E = pg8::EpiBf16{(bf16_t*)(ACT + ACT_KVRAW), 512}; nN = 2; }
                else { g = pg8::Gemm{(const bf16_t*)(ACT + ACT_CKV), (const bf16_t*)(ws + WS_WKV), 256, 256, 0}; E = pg8::EpiBf16{KVb, 2048}; nN = 8; }
                pg8::Order S; S.init(128, nN, G, bid);
                pg8::gemm_phase<pg8::EpiBf16, 0>(lds, xl, g, S, E, TIDNOW());
            }
        } break;
        case K_ATTN: att::attn_phase((char*)lds_raw, (const bf16_t*)(ACT + ACT_Q), KVb, KRb, (bf16_t*)(ACT + ACT_O), TIDNOW(), bid); break;
        case K_FINAL: final_norm(XB, outp, AF(final_g), gw, NGW, lane);
            break;
        }
        if (ph + 1 < NPHASE) xcd_barrier((unsigned*)(ws + WS_BAR), xb_xcc_id(), bst, TIDNOW() == 0);
    }
}

extern "C" void kernel_launch(void* const* d_in, const int* in_sizes, int n_in, void* d_out, int out_size, void* d_ws, size_t ws_size, hipStream_t stream) {
    static int grid = 0;
    if (grid == 0) {
        if (n_in != 24 || out_size != MT * DM || ws_size < WS_END) { fprintf(stderr, "kernel_launch: unexpected shapes (n_in %d out %d ws %zu need %zu)\n", n_in, out_size, ws_size, (size_t)WS_END); grid = -1; return; }
        int dev = 0, cus = 0, per_cu = 0;
        (void)hipGetDevice(&dev);
        if (hipDeviceGetAttribute(&cus, hipDeviceAttributeMultiprocessorCount, dev) != hipSuccess || cus <= 0) cus = 256;
        if (hipFuncSetAttribute((const void*)fwd_megakernel, hipFuncAttributeMaxDynamicSharedMemorySize, LDS_BYTES) != hipSuccess) { fprintf(stderr, "kernel_launch: hipFuncSetAttribute failed\n"); grid = -1; return; }
        if (hipOccupancyMaxActiveBlocksPerMultiprocessor(&per_cu, (const void*)fwd_megakernel, NTHR, LDS_BYTES) != hipSuccess || per_cu < 1) { fprintf(stderr, "kernel_launch: occupancy query gave %d\n", per_cu); per_cu = 1; }
        (void)hipGetLastError();
        grid = cus * per_cu;
    }
    if (grid < 0) return;
    Args a{};
    a.x = (const float*)d_in[0]; a.c = (const float*)d_in[1]; a.pos = (const int*)d_in[2]; a.mod_w = (const float*)d_in[3]; a.mod_b = (const float*)d_in[4];
    a.norm1_g = (const float*)d_in[5]; a.norm2_g = (const float*)d_in[6]; a.pool_w = (const float*)d_in[7]; a.pool_b = (const float*)d_in[8]; a.pool_scale = (const float*)d_in[9];
    a.kv_in_g = (const float*)d_in[10]; a.w_dkv = (const float*)d_in[11]; a.ckv_norm_g = (const float*)d_in[12]; a.w_uk = (const float*)d_in[13]; a.w_uv = (const float*)d_in[14];
    a.w_dq = (const float*)d_in[15]; a.q_norm_g = (const float*)d_in[16]; a.w_uq = (const float*)d_in[17]; a.w_o = (const float*)d_in[18];
    a.w_up = (const float*)d_in[19]; a.conv_w = (const float*)d_in[20]; a.conv_b = (const float*)d_in[21]; a.w_down = (const float*)d_in[22]; a.final_g = (const float*)d_in[23];
    a.out = (float*)d_out; a.ws = (unsigned char*)d_ws;
    if (hipMemsetAsync((char*)d_ws + WS_BAR, 0, 16384, stream) != hipSuccess) { fprintf(stderr, "kernel_launch: hipMemsetAsync failed\n"); return; }
    void* args[] = {&a};
    hipError_t e = hipLaunchCooperativeKernel((const void*)fwd_megakernel, dim3(grid), dim3(NTHR), args, LDS_BYTES, stream);
    if (e != hipSuccess) fprintf(stderr, "kernel_launch: cooperative launch failed: %s (grid %d)\n", hipGetErrorString(e), grid);
}
```
